# Optimizing an MI355X kernel written in HIP

```python
import math
import jax, jax.numpy as jnp
from jax import lax
import numpy as np

D_MODEL = 1024
BATCH = 1
SEQ = 16384
DEPTH = 4

CHUNK = 128
D_MIX = D_MODEL
GMLP_HEADS = 4
GMLP_HEAD_DIM = 64
GMLP_W = GMLP_HEADS * GMLP_HEAD_DIM
SSD_HEADS = 6
SSD_HEAD_DIM = 64
SSD_W = SSD_HEADS * SSD_HEAD_DIM
SSD_GROUPS = 2
SSD_STATE = 64
SSD_CONV = 4
SSD_XBC = SSD_W + 2 * SSD_GROUPS * SSD_STATE
MLA_HEADS = 6
MLA_NOPE = 64
MLA_ROPE = 32
MLA_V = 64
MLA_W = MLA_HEADS * MLA_V
MLA_Q_RANK = 384
MLA_KV_RANK = 256
ROPE_BASE = 10000.0
D_FF = 4 * D_MODEL
EPS = 1e-6
IN_WIDTHS = (2 * GMLP_W, SSD_W, SSD_XBC, SSD_HEADS, MLA_Q_RANK, MLA_KV_RANK, MLA_ROPE)
D_IN = sum(IN_WIDTHS)

kernel_name = "hybrid_gmlp_ssd_mla_block"


def rmsnorm(x, g):
    xf = x.astype(jnp.float32)
    var = jnp.mean(xf * xf, axis=-1, keepdims=True)
    return (xf * lax.rsqrt(var + EPS)).astype(x.dtype) * g


def split_cols(proj):
    idx, acc = [], 0
    for w in IN_WIDTHS[:-1]:
        acc += w
        idx.append(acc)
    return jnp.split(proj, idx, axis=-1)


def rope_tables(S):
    half = MLA_ROPE // 2
    pos = jnp.arange(S, dtype=jnp.float32)
    inv_freq = jnp.power(ROPE_BASE, -jnp.arange(half, dtype=jnp.float32) / half)
    ang = pos[:, None] * inv_freq[None, :]
    return jnp.cos(ang), jnp.sin(ang)


def apply_rope(x, cos, sin):
    c = cos[None, :, None, :].astype(x.dtype)
    s = sin[None, :, None, :].astype(x.dtype)
    x1, x2 = jnp.split(x, 2, axis=-1)
    return jnp.concatenate([x1 * c - x2 * s, x2 * c + x1 * s], axis=-1)


def gmlp_mixer(uv, v_norm_g, w_s, b_s):
    Bsz, S, _ = uv.shape
    nc = S // CHUNK
    uv = jax.nn.gelu(uv)
    u, v = jnp.split(uv, 2, axis=-1)
    v = rmsnorm(v, v_norm_g).reshape(Bsz, nc, CHUNK, GMLP_HEADS, GMLP_HEAD_DIM)
    causal = jnp.tril(jnp.ones((CHUNK, CHUNK), dtype=w_s.dtype))
    mixed = jnp.einsum('hts,bcshd->bcthd', w_s * causal, v)
    mixed = mixed + b_s.T[None, None, :, :, None]
    return u * mixed.reshape(Bsz, S, GMLP_W)


def causal_depthwise_conv(x, w, b):
    K, C = w.shape
    out = lax.conv_general_dilated(
        x, w[:, None, :], window_strides=(1,), padding=((K - 1, 0),),
        dimension_numbers=('NWC', 'WIO', 'NWC'), feature_group_count=C)
    return out + b


def ssd_mixer(z, xbc, dt_raw, conv_w, conv_b, dt_bias, a_log, d_skip, norm_g):
    Bsz, S, _ = xbc.shape
    nc = S // CHUNK
    hpg = SSD_HEADS // SSD_GROUPS
    xbc = jax.nn.silu(causal_depthwise_conv(xbc, conv_w, conv_b))
    xs, Bm, Cm = jnp.split(xbc, [SSD_W, SSD_W + SSD_GROUPS * SSD_STATE], axis=-1)
    xs_c = xs.reshape(Bsz, nc, CHUNK, SSD_HEADS, SSD_HEAD_DIM)
    B_c = Bm.reshape(Bsz, nc, CHUNK, SSD_GROUPS, SSD_STATE)
    C_c = Cm.reshape(Bsz, nc, CHUNK, SSD_GROUPS, SSD_STATE)
    dt = jax.nn.softplus((dt_raw + dt_bias).astype(jnp.float32))
    A = -jnp.exp(a_log.astype(jnp.float32))
    dt_h = dt.reshape(Bsz, nc, CHUNK, SSD_HEADS).transpose(0, 1, 3, 2)
    a_h = jnp.cumsum(dt_h * A[None, None, :, None], axis=-1)
    causal = jnp.tril(jnp.ones((CHUNK, CHUNK), dtype=bool))
    seg = a_h[..., :, None] - a_h[..., None, :]
    decay = jnp.exp(jnp.where(causal, seg, -jnp.inf))
    cb = jnp.einsum('bctgn,bcsgn->bcgts', C_c, B_c)
    cb_h = jnp.repeat(cb, hpg, axis=2)
    w = cb_h * decay * dt_h[:, :, :, None, :]
    y_diag = jnp.einsum('bchts,bcshp->bcthp', w, xs_c)
    B_h = jnp.repeat(B_c, hpg, axis=3)
    C_h = jnp.repeat(C_c, hpg, axis=3)
    decay_to_end = jnp.exp(a_h[..., -1:] - a_h) * dt_h
    states = jnp.einsum('bchs,bcshn,bcshp->bchpn', decay_to_end, B_h, xs_c)
    chunk_decay = jnp.exp(a_h[..., -1])

    def step(h, inp):
        dec, st = inp
        return dec[:, :, None, None] * h + st, h

    h0 = jnp.zeros((Bsz, SSD_HEADS, SSD_HEAD_DIM, SSD_STATE), states.dtype)
    _, h_prev = lax.scan(step, h0, (chunk_decay.transpose(1, 0, 2), states.transpose(1, 0, 2, 3, 4)))
    h_prev = h_prev.transpose(1, 0, 2, 3, 4)
    y_off = jnp.einsum('bcthn,bchpn,bcht->bcthp', C_h, h_prev, jnp.exp(a_h))
    y = y_diag + y_off + xs_c * d_skip[:, None]
    y = y.reshape(Bsz, S, SSD_W).astype(z.dtype)
    yg = (y * jax.nn.silu(z)).reshape(Bsz, S, SSD_GROUPS, SSD_W // SSD_GROUPS)
    return rmsnorm(yg, norm_g.reshape(SSD_GROUPS, -1)).reshape(Bsz, S, SSD_W)


def causal_block_attention(q, k, v, scale):
    Bsz, S, H, Dqk = q.shape
    nq = S // CHUNK
    qb = q.reshape(Bsz, nq, CHUNK, H, Dqk).transpose(1, 0, 3, 2, 4)
    k_pos = jnp.arange(S)

    def one_block(args):
        q_blk, blk = args
        s = jnp.einsum('bhqd,bkhd->bhqk', q_blk, k).astype(jnp.float32) * scale
        q_pos = blk * CHUNK + jnp.arange(CHUNK)
        s = jnp.where(k_pos[None, :] <= q_pos[:, None], s, -jnp.inf)
        p = jax.nn.softmax(s, axis=-1).astype(v.dtype)
        return jnp.einsum('bhqk,bkhd->bqhd', p, v)

    out = lax.map(one_block, (qb, jnp.arange(nq)))
    return out.transpose(1, 0, 2, 3, 4).reshape(Bsz, S, H, v.shape[-1])


def mla_mixer(c_q, c_kv, k_rope_raw, q_norm_g, w_qb, kv_norm_g, w_kvb, cos, sin):
    Bsz, S, _ = c_q.shape
    q = (rmsnorm(c_q, q_norm_g) @ w_qb).reshape(Bsz, S, MLA_HEADS, MLA_NOPE + MLA_ROPE)
    kv = (rmsnorm(c_kv, kv_norm_g) @ w_kvb).reshape(Bsz, S, MLA_HEADS, MLA_NOPE + MLA_V)
    q_nope, q_rope = jnp.split(q, [MLA_NOPE], axis=-1)
    k_nope, v = jnp.split(kv, [MLA_NOPE], axis=-1)
    q_rope = apply_rope(q_rope, cos, sin)
    k_rope = apply_rope(k_rope_raw[:, :, None, :], cos, sin)
    q = jnp.concatenate([q_nope, q_rope], axis=-1)
    k = jnp.concatenate([k_nope, jnp.broadcast_to(k_rope, (Bsz, S, MLA_HEADS, MLA_ROPE))], axis=-1)
    scale = 1.0 / math.sqrt(MLA_NOPE + MLA_ROPE)
    out = causal_block_attention(q, k, v, scale)
    return out.reshape(Bsz, S, MLA_W)


def squared_relu_mlp(h, w1, w2):
    return jnp.square(jax.nn.relu(h @ w1)) @ w2


def setup_inputs(seed: int = 0) -> dict:
    key = jax.random.key(seed)
    ks = jax.random.split(key, 21)

    def nrm(k, shape, scale):
        return jax.random.normal(k, shape, jnp.float32) * scale

    def gain(k, shape):
        return 1.0 + 0.02 * jax.random.normal(k, shape, jnp.float32)

    dt0 = jnp.exp(jax.random.uniform(ks[8], (DEPTH, SSD_HEADS), jnp.float32,
                                     math.log(1e-3), math.log(1e-1)))
    dt_bias = dt0 + jnp.log(-jnp.expm1(-dt0))
    a_log = jnp.log(jax.random.uniform(ks[9], (DEPTH, SSD_HEADS), jnp.float32, 1.0, 16.0))
    return {
        "x": nrm(ks[0], (BATCH, SEQ, D_MODEL), 1.0),
        "norm_mix_g": gain(ks[1], (DEPTH, D_MODEL)),
        "w_in": nrm(ks[2], (DEPTH, D_MODEL, D_IN), D_MODEL ** -0.5),
        "gmlp_v_norm_g": gain(ks[3], (DEPTH, GMLP_W)),
        "gmlp_w_s": nrm(ks[4], (DEPTH, GMLP_HEADS, CHUNK, CHUNK), CHUNK ** -0.5),
        "gmlp_b_s": gain(ks[5], (DEPTH, GMLP_HEADS, CHUNK)),
        "ssd_conv_w": nrm(ks[6], (DEPTH, SSD_CONV, SSD_XBC), SSD_CONV ** -0.5),
        "ssd_conv_b": nrm(ks[7], (DEPTH, SSD_XBC), 0.02),
        "ssd_dt_bias": dt_bias,
        "ssd_a_log": a_log,
        "ssd_d": 1.0 + 0.1 * jax.random.normal(ks[10], (DEPTH, SSD_HEADS), jnp.float32),
        "ssd_norm_g": gain(ks[11], (DEPTH, SSD_W)),
        "mla_q_norm_g": gain(ks[12], (DEPTH, MLA_Q_RANK)),
        "mla_w_qb": nrm(ks[13], (DEPTH, MLA_Q_RANK, MLA_HEADS * (MLA_NOPE + MLA_ROPE)), MLA_Q_RANK ** -0.5),
        "mla_kv_norm_g": gain(ks[14], (DEPTH, MLA_KV_RANK)),
        "mla_w_kvb": nrm(ks[15], (DEPTH, MLA_KV_RANK, MLA_HEADS * (MLA_NOPE + MLA_V)), MLA_KV_RANK ** -0.5),
        "w_out": nrm(ks[16], (DEPTH, D_MIX, D_MODEL), D_MIX ** -0.5),
        "norm_mlp_g": gain(ks[17], (DEPTH, D_MODEL)),
        "mlp_w1": nrm(ks[18], (DEPTH, D_MODEL, D_FF), D_MODEL ** -0.5),
        "mlp_w2": nrm(ks[19], (DEPTH, D_FF, D_MODEL), D_FF ** -0.5),
        "final_norm_g": gain(ks[20], (D_MODEL,)),
    }


def reference(x, norm_mix_g, w_in, gmlp_v_norm_g, gmlp_w_s, gmlp_b_s, ssd_conv_w, ssd_conv_b,
              ssd_dt_bias, ssd_a_log, ssd_d, ssd_norm_g, mla_q_norm_g, mla_w_qb, mla_kv_norm_g,
              mla_w_kvb, w_out, norm_mlp_g, mlp_w1, mlp_w2, final_norm_g):
    S = x.shape[1]
    cos, sin = rope_tables(S)
    for l in range(DEPTH):
        h = rmsnorm(x, norm_mix_g[l])
        uv, z, xbc, dt_raw, c_q, c_kv, k_rope = split_cols(h @ w_in[l])
        y_a = gmlp_mixer(uv, gmlp_v_norm_g[l], gmlp_w_s[l], gmlp_b_s[l])
        y_b = ssd_mixer(z, xbc, dt_raw, ssd_conv_w[l], ssd_conv_b[l], ssd_dt_bias[l],
                        ssd_a_log[l], ssd_d[l], ssd_norm_g[l])
        y_c = mla_mixer(c_q, c_kv, k_rope, mla_q_norm_g[l], mla_w_qb[l], mla_kv_norm_g[l],
                        mla_w_kvb[l], cos, sin)
        mix = jnp.concatenate([y_a, y_b, y_c], axis=-1)
        x = x + mix @ w_out[l]
        x = x + squared_relu_mlp(rmsnorm(x, norm_mlp_g[l]), mlp_w1[l], mlp_w2[l])
    return rmsnorm(x, final_norm_g)
```

```cpp
#include <hip/hip_runtime.h>
#include <hip/hip_cooperative_groups.h>
#include <cstdio>
#include <cstdint>
namespace cg = cooperative_groups;
namespace pg8 {
#define PG8_LAS __attribute__((address_space(3)))
typedef unsigned short bf16_t;
typedef short bf16x8 __attribute__((ext_vector_type(8)));
typedef float f32x4 __attribute__((ext_vector_type(4)));
typedef unsigned u32x4 __attribute__((ext_vector_type(4)));
constexpr int BM = 256, BK = 64, HALF = 128, HTB = HALF * BK * 2  , STAGE_BYTES = 8 * HTB, NXCD = 8, WGM = 8;

__host__ __device__ __forceinline__ int lds_byte(int r, int c) { const int st = (r >> 4) * 2 + (c >> 5), rr = r & 15, cc = c & 31, ob = rr * 64 + cc * 2; return st * 1024 + (ob ^ (((ob >> 9) & 1) << 5)); }
__host__ __device__ __forceinline__ void stage_rc(int b, int& R, int& C) { const int st = b / 1024, sb = b % 1024, swz = sb ^ (((sb >> 9) & 1) << 5); R = (st >> 1) * 16 + swz / 64; C = (st & 1) * 32 + (swz % 64) / 2; }
__host__ __device__ __forceinline__ int perm32(int rho) { const int n = rho >> 4, i = rho & 15; return 8 * (i >> 2) + 4 * n + (i & 3); }

struct Unit { int pm, pn; };
struct Gemm { const bf16_t* A; const bf16_t* Bt; int M, N, K; };

struct StaticOrder {
    int nM, nN, nwg, G, c;
    __host__ __device__ void init(int M, int N, int G_, int c_) { nM = M / BM; nN = N / BM; nwg = nM * nN; G = G_; c = c_; }
    __host__ __device__ bool next(int i, Unit& u) const {
        const long L = (long)i * G + c; if (L >= nwg) return false;
        int wgid = (int)L; { const int q = nwg / NXCD, r = nwg % NXCD, xcd = wgid % NXCD, off = wgid / NXCD; wgid = (xcd < r ? xcd * (q + 1) : r * (q + 1) + (xcd - r) * q) + off; }
        const int nig = WGM * nN, gid = wgid / nig, fm = gid * WGM, gsz = (nM - fm) < WGM ? (nM - fm) : WGM;
        u.pm = fm + ((wgid % nig) % gsz); u.pn = (wgid % nig) / gsz; return true;
    }
    __device__ __forceinline__ void a_ready(const Unit&) const {}
    __device__ __forceinline__ void done(const Unit&) const {}
};

__device__ __forceinline__ unsigned cvt_pk_bf16(float lo, float hi) { unsigned r; asm volatile("v_cvt_pk_bf16_f32 %0, %1, %2" : "=v"(r) : "v"(lo), "v"(hi)); return r; }
template <class Epi, class Sched, bool ALIGN_EPI = false, bool SP2 = false>
__device__ __forceinline__ void gemm_phase(PG8_LAS unsigned char* lds, const Gemm g, const Sched& S, const Epi& E) {
    int tid_l = threadIdx.x; asm volatile("" : "+v"(tid_l));
    const int tid = tid_l, wid = __builtin_amdgcn_readfirstlane(tid >> 6), lane = tid & 63, wr = wid >> 2, wc = wid & 3, fr = lane & 15, fq = lane >> 4;
    int K_l = g.K; asm volatile("" : "+s"(K_l));
    const int K = K_l, nt = K / BK;
    unsigned voffA[2], voffB[2];
#pragma unroll
    for (int i = 0; i < 2; ++i) { int R, C; stage_rc(tid * 16 + i * 8192, R, C); const int Rb = Epi::PERM ? ((R & ~31) + perm32(R & 31)) : R;
        voffA[i] = (unsigned)(R * K + C) * 2u; voffB[i] = (unsigned)(Rb * K + C) * 2u; }
    const size_t kstep = (size_t)(BK * 2);
    const size_t hstep = (size_t)HALF * K * 2;
    const size_t tstep = 2 * hstep;
    const unsigned ldsw = (unsigned)wid * 1024u;
    const int aoff = lds_byte(wr * 64 + fr, fq * 8), boff = lds_byte(wc * 32 + fr, fq * 8);
#define PG8_SA(b, h) (((b) * 2 + (h)) * HTB)
#define PG8_SB(b, h) ((4 + (b) * 2 + (h)) * HTB)
#define PG8_STAGE(bufoff, gbase, voff) do { _Pragma("unroll") for (int _i = 0; _i < 2; ++_i) \
        __builtin_amdgcn_global_load_lds((const unsigned*)((const char*)(gbase) + (voff)[_i]), (PG8_LAS unsigned*)(lds + (bufoff) + ldsw + _i * 8192), 16, 0, 0); } while (0)
#define PG8_LDA(dst, b, h) do { _Pragma("unroll") for (int m = 0; m < 4; ++m) _Pragma("unroll") for (int k = 0; k < 2; ++k) dst[m][k] = *(const PG8_LAS bf16x8*)(lds + PG8_SA(b, h) + aoff + m * 2048 + k * 1024); } while (0)
#define PG8_LDB(dst, b, h) do { _Pragma("unroll") for (int n = 0; n < 2; ++n) _Pragma("unroll") for (int k = 0; k < 2; ++k) dst[n][k] = *(const PG8_LAS bf16x8*)(lds + PG8_SB(b, h) + boff + n * 2048 + k * 1024); } while (0)
#define PG8_MMA(ai, bj, At, Bt) do { __builtin_amdgcn_s_setprio(1); _Pragma("unroll") for (int m = 0; m < 4; ++m) _Pragma("unroll") for (int n = 0; n < 2; ++n) _Pragma("unroll") for (int k = 0; k < 2; ++k) \
        acc[ai][bj][m][n] = __builtin_amdgcn_mfma_f32_16x16x32_bf16(Bt[n][k], At[m][k], acc[ai][bj][m][n], 0, 0, 0); __builtin_amdgcn_s_setprio(0); } while (0)
#define PG8_WAIT_V(n) asm volatile("s_waitcnt vmcnt(" #n ")" ::: "memory")
#define PG8_WAIT_L(n) asm volatile("s_waitcnt lgkmcnt(" #n ")" ::: "memory")
#define PG8_BAR __builtin_amdgcn_s_barrier()
#define PG8_SCHED __builtin_amdgcn_sched_barrier(0)
    Unit cur, nxt; int ui = 0;
    if (!S.next(0, cur)) return;
    f32x4 acc[2][2][4][2];
#pragma unroll
    for (int a = 0; a < 2; ++a)
#pragma unroll
        for (int b = 0; b < 2; ++b)
#pragma unroll
            for (int m = 0; m < 4; ++m)
#pragma unroll
                for (int n = 0; n < 2; ++n) acc[a][b][m][n] = (f32x4){0.f, 0.f, 0.f, 0.f};
    bf16x8 At[4][2], B0[2][2], B1[2][2];
    const char* cA = (const char*)g.A + (size_t)cur.pm * tstep; const char* cB = (const char*)g.Bt + (size_t)cur.pn * tstep;
    S.a_ready(cur);
    if constexpr (SP2) {
        PG8_STAGE(PG8_SB(0, 0), cB, voffB); PG8_STAGE(PG8_SB(0, 1), cB + hstep, voffB); PG8_STAGE(PG8_SA(0, 0), cA, voffA); PG8_STAGE(PG8_SA(0, 1), cA + hstep, voffA);
        if (wr == 1) PG8_BAR;
        PG8_WAIT_V(2); PG8_BAR;
        PG8_STAGE(PG8_SB(1, 0), cB + kstep, voffB); PG8_STAGE(PG8_SA(1, 0), cA + kstep, voffA); PG8_STAGE(PG8_SB(1, 1), cB + hstep + kstep, voffB);
        PG8_WAIT_V(6); PG8_BAR;
    } else {
        PG8_STAGE(PG8_SB(0, 0), cB, voffB); PG8_STAGE(PG8_SA(0, 0), cA, voffA); PG8_STAGE(PG8_SB(0, 1), cB + hstep, voffB); PG8_STAGE(PG8_SA(0, 1), cA + hstep, voffA);
        if (wr == 1) PG8_BAR;
        PG8_WAIT_V(4); PG8_BAR;
        PG8_STAGE(PG8_SB(1, 0), cB + kstep, voffB); PG8_STAGE(PG8_SA(1, 0), cA + kstep, voffA); PG8_STAGE(PG8_SB(1, 1), cB + hstep + kstep, voffB);
        PG8_WAIT_V(6); PG8_BAR;
    }
    for (;;) {
        const bool has_next = S.next(ui + 1, nxt);
        const char* nA = has_next ? (const char*)g.A + (size_t)nxt.pm * tstep : cA; const char* nB = has_next ? (const char*)g.Bt + (size_t)nxt.pn * tstep : cB;
        for (int t = 0; t < nt; t += 2) {
            const bool last = (t == nt - 2);
            const char* a1 = cA + (size_t)(t + 1) * kstep;
            const char* a2 = last ? nA : cA + (size_t)(t + 2) * kstep; const char* b2 = last ? nB : cB + (size_t)(t + 2) * kstep;
            const char* a3 = a2 + kstep; const char* b3 = b2 + kstep;
            if (last && has_next) S.a_ready(nxt);
            if constexpr (SP2) {
            PG8_LDB(B0, 0, 0); PG8_LDB(B1, 0, 1); PG8_SCHED; PG8_LDA(At, 0, 0); PG8_STAGE(PG8_SA(1, 1), a1 + hstep, voffA);
            PG8_WAIT_V(8); PG8_WAIT_L(0); PG8_BAR; PG8_MMA(0, 0, At, B0); PG8_MMA(0, 1, At, B1); PG8_BAR; PG8_SCHED;
            PG8_LDA(At, 0, 1); PG8_STAGE(PG8_SB(0, 0), b2, voffB); PG8_STAGE(PG8_SB(0, 1), b2 + hstep, voffB); PG8_STAGE(PG8_SA(0, 0), a2, voffA);
            PG8_WAIT_V(8); PG8_WAIT_L(0); PG8_BAR; PG8_MMA(1, 0, At, B0); PG8_MMA(1, 1, At, B1); PG8_BAR; PG8_SCHED;
            PG8_LDB(B0, 1, 0); PG8_LDB(B1, 1, 1); PG8_SCHED; PG8_LDA(At, 1, 0); PG8_STAGE(PG8_SA(0, 1), a2 + hstep, voffA);
            PG8_WAIT_V(8); PG8_WAIT_L(0); PG8_BAR; PG8_MMA(0, 0, At, B0); PG8_MMA(0, 1, At, B1); PG8_BAR; PG8_SCHED;
            PG8_LDA(At, 1, 1); PG8_STAGE(PG8_SB(1, 0), b3, voffB); PG8_STAGE(PG8_SB(1, 1), b3 + hstep, voffB); PG8_STAGE(PG8_SA(1, 0), a3, voffA);
            PG8_WAIT_V(8); PG8_WAIT_L(0); PG8_BAR; PG8_MMA(1, 0, At, B0); PG8_MMA(1, 1, At, B1); PG8_BAR; PG8_SCHED;
            } else {
            PG8_LDB(B0, 0, 0); PG8_SCHED; PG8_LDA(At, 0, 0); PG8_STAGE(PG8_SA(1, 1), a1 + hstep, voffA);
            PG8_WAIT_L(8); PG8_BAR; PG8_WAIT_L(0); PG8_MMA(0, 0, At, B0); PG8_BAR; PG8_SCHED;
            PG8_LDB(B1, 0, 1); PG8_STAGE(PG8_SB(0, 0), b2, voffB);
            PG8_BAR; PG8_WAIT_L(0); PG8_MMA(0, 1, At, B1); PG8_BAR;
            PG8_LDA(At, 0, 1); PG8_STAGE(PG8_SA(0, 0), a2, voffA);
            PG8_BAR; PG8_WAIT_L(0); PG8_MMA(1, 0, At, B0); PG8_BAR; PG8_SCHED;
            PG8_STAGE(PG8_SB(0, 1), b2 + hstep, voffB);
            PG8_WAIT_V(6); PG8_BAR; PG8_MMA(1, 1, At, B1); PG8_BAR;
            PG8_LDB(B0, 1, 0); PG8_SCHED; PG8_LDA(At, 1, 0); PG8_STAGE(PG8_SA(0, 1), a2 + hstep, voffA);
            PG8_WAIT_L(8); PG8_BAR; PG8_WAIT_L(0); PG8_MMA(0, 0, At, B0); PG8_BAR; PG8_SCHED;
            PG8_LDB(B1, 1, 1); PG8_STAGE(PG8_SB(1, 0), b3, voffB);
            PG8_BAR; PG8_WAIT_L(0); PG8_MMA(0, 1, At, B1); PG8_BAR;
            PG8_LDA(At, 1, 1); PG8_STAGE(PG8_SA(1, 0), a3, voffA);
            PG8_BAR; PG8_WAIT_L(0); PG8_MMA(1, 0, At, B0); PG8_BAR; PG8_SCHED;
            PG8_STAGE(PG8_SB(1, 1), b3 + hstep, voffB);
            PG8_WAIT_V(6); PG8_BAR; PG8_MMA(1, 1, At, B1); PG8_BAR;
            }
        }
        if constexpr (ALIGN_EPI) { if (wr == 0) PG8_BAR; }
        if constexpr (!Epi::AFTER_DRAIN) { E(acc, cur, wr, wc, fr, fq); S.done(cur); }
        if (!has_next) break;
#pragma unroll
        for (int a = 0; a < 2; ++a)
#pragma unroll
            for (int b = 0; b < 2; ++b)
#pragma unroll
                for (int m = 0; m < 4; ++m)
#pragma unroll
                    for (int n = 0; n < 2; ++n) acc[a][b][m][n] = (f32x4){0.f, 0.f, 0.f, 0.f};
        cur = nxt; cA = nA; cB = nB; ++ui;
        if constexpr (ALIGN_EPI) { if (wr == 1) PG8_BAR; }
    }
    PG8_WAIT_V(0);
    if constexpr (!ALIGN_EPI) { if (wr == 0) PG8_BAR; }
    PG8_BAR;
    if constexpr (Epi::AFTER_DRAIN) { E.fused(acc, cur, wr, wc, fr, fq, lds, wid, lane); S.done(cur); }
#undef PG8_SA
#undef PG8_SB
#undef PG8_STAGE
#undef PG8_LDA
#undef PG8_LDB
#undef PG8_MMA
#undef PG8_WAIT_V
#undef PG8_WAIT_L
#undef PG8_BAR
#undef PG8_SCHED
}
}

#ifndef PG8_SP2
#define PG8_SP2 true
#endif
#ifndef PG8_ALIGN
#define PG8_ALIGN true
#endif
#define DI __device__ __forceinline__
typedef unsigned short us;
typedef short bf16x8 __attribute__((ext_vector_type(8)));
typedef short s16x4 __attribute__((ext_vector_type(4)));
typedef float f32x4 __attribute__((ext_vector_type(4)));
typedef float f32x16 __attribute__((ext_vector_type(16)));
typedef unsigned u32x4 __attribute__((ext_vector_type(4)));
typedef unsigned u32x2 __attribute__((ext_vector_type(2)));
#define MFMA32(a, b, c) __builtin_amdgcn_mfma_f32_32x32x16_bf16((a), (b), (c), 0, 0, 0)

constexpr int M = 16384, DM = 1024, NL = 4, FF = 4096, DINP = 2304, DIN = 2214;
constexpr float EPS = 1e-6f;
constexpr size_t MiB = 1u << 20;
constexpr size_t WS_CTL = 0, WS_ROPE = 1 * MiB, WS_SSQ = 3 * MiB, WS_DT = 5 * MiB, WS_ACUM = 5 * MiB + 512 * 1024, WS_DEC = 6 * MiB;
constexpr size_t WS_WIN = 8 * MiB, WS_WQB = 12 * MiB + 512 * 1024, WS_WKN = 13 * MiB + 256 * 1024, WS_WV = 13 * MiB + 512 * 1024, WS_WOUT = 14 * MiB, WS_W1 = 16 * MiB, WS_W2 = 24 * MiB;
constexpr size_t WS_XN = 32 * MiB, WS_Y = 32 * MiB  , WS_MIX = 64 * MiB, WS_H = 96 * MiB;
constexpr size_t WS_U = 96 * MiB, WS_V = 104 * MiB, WS_ZS = 112 * MiB, WS_XBC = 124 * MiB, WS_CQ = 144 * MiB, WS_CKV = 156 * MiB, WS_Q = 164 * MiB, WS_K = 182 * MiB, WS_VT = 200 * MiB, WS_CC = 212 * MiB;
constexpr size_t WS_ST = 224 * MiB, WS_SSQX = 236 * MiB, WS_WOUT2 = 238 * MiB, WS_RSTD = 240 * MiB, WS_END = 241 * MiB;
constexpr int LDS_BYTES = 147456;
constexpr float QSCALE = 0.10206207261596575f * 1.4426950408889634f;

DI float bf2f(us b) { return __uint_as_float(((unsigned)b) << 16); }
typedef __bf16 bf16x2_t __attribute__((ext_vector_type(2)));
typedef float f32x2_t __attribute__((ext_vector_type(2)));
DI unsigned pk2(float lo, float hi) { f32x2_t v = {lo, hi}; bf16x2_t b = __builtin_convertvector(v, bf16x2_t); return __builtin_bit_cast(unsigned, b); }
DI us f2bf(float f) { return (us)(pk2(f, 0.f) & 0xffffu); }
DI int crow(int i, int hf) { return (i & 3) + 8 * (i >> 2) + 4 * hf; }
DI float wave_sum(float v) {
#pragma unroll
    for (int o = 1; o < 64; o <<= 1) v += __shfl_xor(v, o);
    return v;
}
DI float gelu_tanh(float x) { const float u = 0.7978845608028654f * (x + 0.044715f * x * x * x); return x * __builtin_amdgcn_rcpf(1.f + __builtin_amdgcn_exp2f(-2.885390081777927f * u)); }
DI float silu(float x) { return x * __builtin_amdgcn_rcpf(1.f + __builtin_amdgcn_exp2f(-1.4426950408889634f * x)); }
DI float softplus(float x) { return x > 20.f ? x : log1pf(__expf(x)); }
DI int rope_src(int j) { const int g = j >> 3, w = j & 7, i = g * 4 + (w & 3); return (w < 4) ? i : 16 + i; }
#define LDS_WAIT() asm volatile("s_waitcnt lgkmcnt(0)" ::: "memory")

DI void mm32(f32x16& acc, const us* A, int lda, const us* B, int ldb, int ksteps, int lane) {
    const int r = lane & 31, hf = lane >> 5;
    const us* ap = A + r * lda + 8 * hf; const us* bp = B + r * ldb + 8 * hf;
    for (int ks = 0; ks < ksteps; ++ks) { const bf16x8 a = *(const bf16x8*)(ap + 16 * ks); const bf16x8 b = *(const bf16x8*)(bp + 16 * ks); acc = MFMA32(a, b, acc); }
}

struct Params { const float* in[21]; float* out; unsigned char* ws; };

template <int MODE> DI int src_col(int r) {
    if (MODE == 0) return r;
    if (MODE == 1) { if (r < 1536) return r; if (r < 2176) return r + 6; if (r < 2208) return 2182 + rope_src(r - 2176); if (r < 2214) return 1536 + (r - 2208); return -1; }
    if (MODE == 2) { if (r >= 576) return -1; const int hd = r / 96, w = r % 96; return w < 64 ? r : hd * 96 + 64 + rope_src(w - 64); }
    if (MODE == 3) { if (r >= 384) return -1; return (r >> 6) * 128 + (r & 63); }
    if (r >= 384) return -1; return (r >> 6) * 128 + 64 + (r & 63);
}
template <int MODE> DI void tr_item(const float* __restrict__ W, int K, int Nsrc, us* WT, const float* gk, float* scr, int item, int nblk, int lane) {
    asm volatile("" : "+v"(lane));
    const int kb = item / nblk, nb = item % nblk, k0 = 64 * kb, n0 = 32 * nb;
    const int sc = src_col<MODE>(n0 + (lane & 31));
#pragma unroll 8
    for (int i = 0; i < 32; ++i) { const int kk = 2 * i + (lane >> 5); float v = sc >= 0 ? W[(size_t)(k0 + kk) * Nsrc + sc] : 0.f; if (gk) v *= gk[k0 + kk]; scr[kk * 33 + (lane & 31)] = v; }
    LDS_WAIT();
    const int c = lane & 7;
#pragma unroll
    for (int j = 0; j < 4; ++j) { const int n = (lane >> 3) + 8 * j; const float* s = scr + (8 * c) * 33 + n;
        u32x4 o; o.x = pk2(s[0 * 33], s[1 * 33]); o.y = pk2(s[2 * 33], s[3 * 33]); o.z = pk2(s[4 * 33], s[5 * 33]); o.w = pk2(s[6 * 33], s[7 * 33]);
        *(u32x4*)(WT + (size_t)(n0 + n) * K + k0 + 8 * c) = o; }
    LDS_WAIT();
}

DI void norm_rows_bf16(const float* x, const float* g, us* XN, int gw, int NGW, int lane) {
    asm volatile("" : "+v"(lane));
    f32x4 gv[4];
#pragma unroll
    for (int j = 0; j < 4; ++j) gv[j] = *(const f32x4*)(g + 4 * lane + 256 * j);
    for (int m = gw; m < M; m += NGW) {
        const f32x4* xr = (const f32x4*)(x + (size_t)m * DM) + lane;
        f32x4 v[4]; float s = 0.f;
#pragma unroll
        for (int j = 0; j < 4; ++j) { v[j] = xr[64 * j]; s += (v[j].x * v[j].x + v[j].y * v[j].y) + (v[j].z * v[j].z + v[j].w * v[j].w); }
        const float rstd = rsqrtf(wave_sum(s) * (1.f / DM) + EPS);
        u32x2* o = (u32x2*)(XN + (size_t)m * DM) + lane;
#pragma unroll
        for (int j = 0; j < 4; ++j) { u32x2 w; w.x = pk2(v[j].x * rstd * gv[j].x, v[j].y * rstd * gv[j].y); w.y = pk2(v[j].z * rstd * gv[j].z, v[j].w * rstd * gv[j].w); o[64 * j] = w; }
    }
}
DI void x_to_bf16_ssq(const float* x, us* XB, float* SSQX, int gw, int NGW, int lane) {
    asm volatile("" : "+v"(lane));
    for (int m = gw; m < M; m += NGW) {
        const f32x4* xr = (const f32x4*)(x + (size_t)m * DM) + lane;
        f32x4 v[4]; float s = 0.f;
#pragma unroll
        for (int j = 0; j < 4; ++j) { v[j] = xr[64 * j]; s += (v[j].x * v[j].x + v[j].y * v[j].y) + (v[j].z * v[j].z + v[j].w * v[j].w); }
        s = wave_sum(s);
        u32x2* o = (u32x2*)(XB + (size_t)m * DM) + lane;
#pragma unroll
        for (int j = 0; j < 4; ++j) { u32x2 w; w.x = pk2(v[j].x, v[j].y); w.y = pk2(v[j].z, v[j].w); o[64 * j] = w; }
        if (lane < 32) SSQX[m * 32 + lane] = lane == 0 ? s : 0.f;
    }
}
DI void norm_rows_out(const us* xb, float* out, const float* g, int gw, int NGW, int lane) {
    asm volatile("" : "+v"(lane));
    f32x4 gv[4];
#pragma unroll
    for (int j = 0; j < 4; ++j) gv[j] = *(const f32x4*)(g + 4 * lane + 256 * j);
    for (int m = gw; m < M; m += NGW) {
        const u32x2* xr = (const u32x2*)(xb + (size_t)m * DM) + lane;
        f32x4 v[4]; float s = 0.f;
#pragma unroll
        for (int j = 0; j < 4; ++j) { const u32x2 w = xr[64 * j]; v[j] = (f32x4){__uint_as_float(w.x << 16), __uint_as_float(w.x & 0xffff0000u), __uint_as_float(w.y << 16), __uint_as_float(w.y & 0xffff0000u)};
            s += (v[j].x * v[j].x + v[j].y * v[j].y) + (v[j].z * v[j].z + v[j].w * v[j].w); }
        const float rstd = rsqrtf(wave_sum(s) * (1.f / DM) + EPS);
        f32x4* o = (f32x4*)(out + (size_t)m * DM) + lane;
#pragma unroll
        for (int j = 0; j < 4; ++j) o[64 * j] = v[j] * rstd * gv[j];
    }
}

using pg8::Unit;
DI void st_bf16x8(us* p, f32x4 a, f32x4 b) { u32x4 w; w.x = pk2(a[0], a[1]); w.y = pk2(a[2], a[3]); w.z = pk2(b[0], b[1]); w.w = pk2(b[2], b[3]); *(u32x4*)p = w; }
DI float sq8(f32x4 a, f32x4 b) { return (a[0] * a[0] + a[1] * a[1]) + (a[2] * a[2] + a[3] * a[3]) + (b[0] * b[0] + b[1] * b[1]) + (b[2] * b[2] + b[3] * b[3]); }

DI float rstd_x(const float* SSQX, int row) {
    const f32x4* p = (const f32x4*)(SSQX + (size_t)row * 32); f32x4 s = p[0];
#pragma unroll
    for (int j = 1; j < 8; ++j) s += p[j];
    return rsqrtf(((s[0] + s[1]) + (s[2] + s[3])) * (1.f / DM) + EPS);
}
DI void prep_rstd(const pg8::StaticOrder& S, const float* SSQX, float* RSTD) {
    int tid = threadIdx.x; asm volatile("" : "+v"(tid));
    Unit u;
    for (int i = 0; S.next(i, u); ++i) {
        const int row = u.pm * 256 + (tid >> 1);
        const f32x4* p = (const f32x4*)(SSQX + (size_t)row * 32 + (tid & 1) * 16);
        const f32x4 s = (p[0] + p[1]) + (p[2] + p[3]);
        float t = (s[0] + s[1]) + (s[2] + s[3]); t += __shfl_xor(t, 1);
        if ((tid & 1) == 0) RSTD[row] = rsqrtf(t * (1.f / DM) + EPS);
    }
    asm volatile("s_waitcnt vmcnt(0)" ::: "memory");
    __syncthreads();
}
struct EpiIn {
    static constexpr bool PERM = true, AFTER_DRAIN = false;
    unsigned char* ws;
    DI void operator()(const f32x4 (&acc)[2][2][4][2], const Unit& u, int wr, int wc, int fr, int fq) const {
        asm volatile("" : "+v"(fr), "+v"(fq));
        us* U = (us*)(ws + WS_U); us* V = (us*)(ws + WS_V); us* ZS = (us*)(ws + WS_ZS); us* XBC = (us*)(ws + WS_XBC); us* CQ = (us*)(ws + WS_CQ); us* CKV = (us*)(ws + WS_CKV); us* K = (us*)(ws + WS_K);
        float* SSQ = (float*)(ws + WS_SSQ); float* DT = (float*)(ws + WS_DT); const float* rope = (const float*)(ws + WS_ROPE);
        float rxa[2][4];
#pragma unroll
        for (int ai = 0; ai < 2; ++ai)
#pragma unroll
            for (int m = 0; m < 4; ++m) rxa[ai][m] = ((const float*)(ws + WS_RSTD))[u.pm * 256 + ai * 128 + wr * 64 + m * 16 + fr];
#pragma unroll
        for (int bj = 0; bj < 2; ++bj) {
            const int sg = 2 * u.pn + bj, c0 = 32 * wc + 8 * fq;
#pragma unroll
            for (int ai = 0; ai < 2; ++ai)
#pragma unroll
                for (int m = 0; m < 4; ++m) {
                    const int row = u.pm * 256 + ai * 128 + wr * 64 + m * 16 + fr;
                    const float rx = rxa[ai][m];
                    f32x4 v0 = acc[ai][bj][m][0] * rx, v1 = acc[ai][bj][m][1] * rx;
                    if (sg < 4) {
#pragma unroll
                        for (int e = 0; e < 4; ++e) { v0[e] = gelu_tanh(v0[e]); v1[e] = gelu_tanh(v1[e]); }
                        st_bf16x8((sg < 2 ? U : V) + (size_t)row * 256 + (sg & 1) * 128 + c0, v0, v1);
                        if (sg >= 2) { float s = sq8(v0, v1); s += __shfl_xor(s, 16); s += __shfl_xor(s, 32); if (fq == 0) SSQ[row * 32 + (sg - 2) * 4 + wc] = s; }
                    } else if (sg < 7) {
#pragma unroll
                        for (int e = 0; e < 4; ++e) { v0[e] = silu(v0[e]); v1[e] = silu(v1[e]); }
                        st_bf16x8(ZS + (size_t)row * 384 + (sg - 4) * 128 + c0, v0, v1);
                    } else if (sg < 12) {
                        st_bf16x8(XBC + (size_t)row * 640 + (sg - 7) * 128 + c0, v0, v1);
                    } else if (sg < 15) {
                        st_bf16x8(CQ + (size_t)row * 384 + (sg - 12) * 128 + c0, v0, v1);
                        float s = sq8(v0, v1); s += __shfl_xor(s, 16); s += __shfl_xor(s, 32); if (fq == 0) SSQ[row * 32 + 8 + (sg - 12) * 4 + wc] = s;
                    } else if (sg < 17) {
                        st_bf16x8(CKV + (size_t)row * 256 + (sg - 15) * 128 + c0, v0, v1);
                        float s = sq8(v0, v1); s += __shfl_xor(s, 16); s += __shfl_xor(s, 32); if (fq == 0) SSQ[row * 32 + 20 + (sg - 15) * 4 + wc] = s;
                    } else {
                        if (wc == 0) {
                            const f32x4 cs0 = *(const f32x4*)(rope + (size_t)row * 32 + 8 * fq), cs1 = *(const f32x4*)(rope + (size_t)row * 32 + 8 * fq + 4);
                            const float c[4] = {cs0[0], cs0[2], cs1[0], cs1[2]}, s[4] = {cs0[1], cs0[3], cs1[1], cs1[3]};
                            f32x4 o1, o2;
#pragma unroll
                            for (int e = 0; e < 4; ++e) { o1[e] = v0[e] * c[e] - v1[e] * s[e]; o2[e] = v1[e] * c[e] + v0[e] * s[e]; }
#pragma unroll
                            for (int hd = 0; hd < 6; ++hd) st_bf16x8(K + ((size_t)hd * M + row) * 96 + 64 + 8 * fq, o1, o2);
                        } else if (wc == 1 && fq == 0) { *(f32x4*)(DT + row * 8) = v0; *(f32x4*)(DT + row * 8 + 4) = v1; }
                    }
                }
        }
    }
};
struct EpiQ {
    static constexpr bool PERM = true, AFTER_DRAIN = false;
    us* Q; const float* SSQ; const float* rope;
    DI void operator()(const f32x4 (&acc)[2][2][4][2], const Unit& u, int wr, int wc, int fr, int fq) const {
        asm volatile("" : "+v"(fr), "+v"(fq));
#pragma unroll
        for (int ai = 0; ai < 2; ++ai)
#pragma unroll
            for (int m = 0; m < 4; ++m) {
                const int row = u.pm * 256 + ai * 128 + wr * 64 + m * 16 + fr;
                const f32x4 a = *(const f32x4*)(SSQ + row * 32 + 8), b = *(const f32x4*)(SSQ + row * 32 + 12), c = *(const f32x4*)(SSQ + row * 32 + 16);
                const float ss = ((a[0] + a[1]) + (a[2] + a[3])) + ((b[0] + b[1]) + (b[2] + b[3])) + ((c[0] + c[1]) + (c[2] + c[3]));
                const float sc = rsqrtf(ss * (1.f / 384.f) + EPS) * QSCALE;
#pragma unroll
                for (int bj = 0; bj < 2; ++bj) {
                    const int colb = u.pn * 256 + bj * 128 + 32 * wc;
                    if (colb >= 576) continue;
                    f32x4 v0 = acc[ai][bj][m][0] * sc, v1 = acc[ai][bj][m][1] * sc;
                    if ((colb >> 5) % 3 == 2) {
                        const f32x4 cs0 = *(const f32x4*)(rope + (size_t)row * 32 + 8 * fq), cs1 = *(const f32x4*)(rope + (size_t)row * 32 + 8 * fq + 4);
                        const float cc[4] = {cs0[0], cs0[2], cs1[0], cs1[2]}, sn[4] = {cs0[1], cs0[3], cs1[1], cs1[3]};
                        f32x4 o1, o2;
#pragma unroll
                        for (int e = 0; e < 4; ++e) { o1[e] = v0[e] * cc[e] - v1[e] * sn[e]; o2[e] = v1[e] * cc[e] + v0[e] * sn[e]; }
                        v0 = o1; v1 = o2;
                    }
                    st_bf16x8(Q + ((size_t)(colb / 96) * M + row) * 96 + (colb % 96) + 8 * fq, v0, v1);
                }
            }
    }
};
struct EpiKn {
    static constexpr bool PERM = true, AFTER_DRAIN = false;
    us* K; const float* SSQ;
    DI void operator()(const f32x4 (&acc)[2][2][4][2], const Unit& u, int wr, int wc, int fr, int fq) const {
        asm volatile("" : "+v"(fr), "+v"(fq));
#pragma unroll
        for (int ai = 0; ai < 2; ++ai)
#pragma unroll
            for (int m = 0; m < 4; ++m) {
                const int row = u.pm * 256 + ai * 128 + wr * 64 + m * 16 + fr;
                const f32x4 a = *(const f32x4*)(SSQ + row * 32 + 20), b = *(const f32x4*)(SSQ + row * 32 + 24);
                const float sc = rsqrtf((((a[0] + a[1]) + (a[2] + a[3])) + ((b[0] + b[1]) + (b[2] + b[3]))) * (1.f / 256.f) + EPS);
#pragma unroll
                for (int bj = 0; bj < 2; ++bj) {
                    const int col = u.pn * 256 + bj * 128 + 32 * wc + 8 * fq;
                    if (col >= 384) continue;
                    st_bf16x8(K + ((size_t)(col >> 6) * M + row) * 96 + (col & 63), acc[ai][bj][m][0] * sc, acc[ai][bj][m][1] * sc);
                }
            }
    }
};
struct EpiVt {
    static constexpr bool PERM = true, AFTER_DRAIN = false;
    us* VT; const float* SSQ;
    DI void operator()(const f32x4 (&acc)[2][2][4][2], const Unit& u, int wr, int wc, int fr, int fq) const {
        asm volatile("" : "+v"(fr), "+v"(fq));
#pragma unroll
        for (int bj = 0; bj < 2; ++bj) {
            const int tok0 = u.pn * 256 + bj * 128 + 32 * wc + 8 * fq;
            float rs[8];
#pragma unroll
            for (int e = 0; e < 8; ++e) { const f32x4 a = *(const f32x4*)(SSQ + (tok0 + e) * 32 + 20), b = *(const f32x4*)(SSQ + (tok0 + e) * 32 + 24);
                rs[e] = rsqrtf((((a[0] + a[1]) + (a[2] + a[3])) + ((b[0] + b[1]) + (b[2] + b[3]))) * (1.f / 256.f) + EPS); }
#pragma unroll
            for (int ai = 0; ai < 2; ++ai)
#pragma unroll
                for (int m = 0; m < 4; ++m) {
                    const int f = u.pm * 256 + ai * 128 + wr * 64 + m * 16 + fr;
                    if (f >= 384) continue;
                    f32x4 v0 = acc[ai][bj][m][0], v1 = acc[ai][bj][m][1];
#pragma unroll
                    for (int e = 0; e < 4; ++e) { v0[e] *= rs[e]; v1[e] *= rs[4 + e]; }
                    st_bf16x8(VT + (size_t)f * M + tok0, v0, v1);
                }
        }
    }
};
struct EpiRes {
    static constexpr bool PERM = true, AFTER_DRAIN = false;
    us* XB; float* SSQX;
    DI void operator()(const f32x4 (&acc)[2][2][4][2], const Unit& u, int wr, int wc, int fr, int fq) const {
        asm volatile("" : "+v"(fr), "+v"(fq));
#pragma unroll
        for (int ai = 0; ai < 2; ++ai)
#pragma unroll
            for (int m = 0; m < 4; ++m) {
                const int row = u.pm * 256 + ai * 128 + wr * 64 + m * 16 + fr;
#pragma unroll
                for (int bj = 0; bj < 2; ++bj) {
                    const size_t o = (size_t)row * DM + u.pn * 256 + bj * 128 + 32 * wc + 8 * fq;
                    const u32x4 xv = *(const u32x4*)(XB + o);
                    const f32x4 x0 = (f32x4){__uint_as_float(xv.x << 16), __uint_as_float(xv.x & 0xffff0000u), __uint_as_float(xv.y << 16), __uint_as_float(xv.y & 0xffff0000u)} + acc[ai][bj][m][0];
                    const f32x4 x1 = (f32x4){__uint_as_float(xv.z << 16), __uint_as_float(xv.z & 0xffff0000u), __uint_as_float(xv.w << 16), __uint_as_float(xv.w & 0xffff0000u)} + acc[ai][bj][m][1];
                    st_bf16x8(XB + o, x0, x1);
                    float s = sq8(x0, x1); s += __shfl_xor(s, 16); s += __shfl_xor(s, 32);
                    if (fq == 0) SSQX[row * 32 + u.pn * 8 + bj * 4 + wc] = s;
                }
            }
    }
};
struct EpiRelu2 {
    static constexpr bool PERM = true, AFTER_DRAIN = false;
    us* H; const float* RSTD;
    DI void operator()(const f32x4 (&acc)[2][2][4][2], const Unit& u, int wr, int wc, int fr, int fq) const {
        asm volatile("" : "+v"(fr), "+v"(fq));
        float rxa[2][4];
#pragma unroll
        for (int ai = 0; ai < 2; ++ai)
#pragma unroll
            for (int m = 0; m < 4; ++m) rxa[ai][m] = RSTD[u.pm * 256 + ai * 128 + wr * 64 + m * 16 + fr];
#pragma unroll
        for (int ai = 0; ai < 2; ++ai)
#pragma unroll
            for (int m = 0; m < 4; ++m) {
                const int row = u.pm * 256 + ai * 128 + wr * 64 + m * 16 + fr;
                const float rx = rxa[ai][m];
#pragma unroll
                for (int bj = 0; bj < 2; ++bj) {
                    f32x4 v0 = acc[ai][bj][m][0], v1 = acc[ai][bj][m][1];
#pragma unroll
                    for (int e = 0; e < 4; ++e) { const float a = fmaxf(v0[e], 0.f) * rx, b = fmaxf(v1[e], 0.f) * rx; v0[e] = a * a; v1[e] = b * b; }
                    st_bf16x8(H + (size_t)row * FF + u.pn * 256 + bj * 128 + 32 * wc + 8 * fq, v0, v1);
                }
            }
    }
};
DI void ld16bf(const us* p, float* o) {
    const u32x4 a = *(const u32x4*)p, b = *(const u32x4*)(p + 8);
    const unsigned w[8] = {a.x, a.y, a.z, a.w, b.x, b.y, b.z, b.w};
#pragma unroll
    for (int j = 0; j < 8; ++j) { o[2 * j] = __uint_as_float(w[j] << 16); o[2 * j + 1] = __uint_as_float(w[j] & 0xffff0000u); }
}
DI void conv16(const us* XBC, int row, int col, const float* cw, const float* cb, float* o) {
#pragma unroll
    for (int j = 0; j < 16; ++j) o[j] = cb[col + j];
#pragma unroll
    for (int k = 0; k < 4; ++k) {
        const int r = row - 3 + k;
        if (r >= 0) { float x[16]; ld16bf(XBC + (size_t)r * 640 + col, x);
#pragma unroll
            for (int j = 0; j < 16; ++j) o[j] += cw[k * 640 + col + j] * x[j]; }
    }
#pragma unroll
    for (int j = 0; j < 16; ++j) o[j] = silu(o[j]);
}
DI void st16bf(us* p, const float* o) {
    u32x4 a, b; a.x = pk2(o[0], o[1]); a.y = pk2(o[2], o[3]); a.z = pk2(o[4], o[5]); a.w = pk2(o[6], o[7]); b.x = pk2(o[8], o[9]); b.y = pk2(o[10], o[11]); b.z = pk2(o[12], o[13]); b.w = pk2(o[14], o[15]);
    *(u32x4*)p = a; *(u32x4*)(p + 8) = b;
}

struct ConvIn { u32x2 v[7]; f32x4 w[4]; f32x4 b; };
DI void conv4x4_load(ConvIn& ci, const us* XBC, int row0, int col, const float* cw, const float* cb) {
#pragma unroll
    for (int r7 = 0; r7 < 7; ++r7) { const int rr = row0 - 3 + r7; ci.v[r7] = (u32x2){0u, 0u}; if (rr >= 0) ci.v[r7] = *(const u32x2*)(XBC + (size_t)rr * 640 + col); }
#pragma unroll
    for (int k = 0; k < 4; ++k) ci.w[k] = *(const f32x4*)(cw + k * 640 + col);
    ci.b = *(const f32x4*)(cb + col);
}
DI void conv4x4_compute(const ConvIn& ci, float (&o)[4][4]) {
    float x[7][4];
#pragma unroll
    for (int r7 = 0; r7 < 7; ++r7) { const u32x2 v = ci.v[r7];
        x[r7][0] = __uint_as_float(v.x << 16); x[r7][1] = __uint_as_float(v.x & 0xffff0000u); x[r7][2] = __uint_as_float(v.y << 16); x[r7][3] = __uint_as_float(v.y & 0xffff0000u); }
#pragma unroll
    for (int tt = 0; tt < 4; ++tt)
#pragma unroll
        for (int j = 0; j < 4; ++j) o[tt][j] = silu(ci.b[j] + (ci.w[0][j] * x[tt][j] + ci.w[1][j] * x[tt + 1][j]) + (ci.w[2][j] * x[tt + 2][j] + ci.w[3][j] * x[tt + 3][j]));
}
DI void conv4x4(const us* XBC, int row0, int col, const float* cw, const float* cb, float (&o)[4][4]) { ConvIn ci; conv4x4_load(ci, XBC, row0, col, cw, cb); conv4x4_compute(ci, o); }
DI u32x2 pk4(float a, float b, float c, float d) { u32x2 r; r.x = pk2(a, b); r.y = pk2(c, d); return r; }
DI void ssd_item(unsigned char* smem, int c, int g, const us* XBC, const float* DT, const float* cw, const float* cb, const float* dt_bias, const float* a_log, const float* d_skip,
                 us* Y, float* ST, float* ACUM, float* DEC, us* CC) {
    us* Cs = (us*)smem; us* Bs = (us*)(smem + 18432); us* BT = (us*)(smem + 36864); us* XT = (us*)(smem + 54272); us* XS = (us*)(smem + 71680); us* Wm = (us*)(smem + 89088);
    float* av = (float*)(smem + 123904); float* dtv = (float*)(smem + 125440);
    int tid_l = threadIdx.x; asm volatile("" : "+v"(tid_l));
    const int tid = tid_l, wave = tid >> 6, lane = tid & 63, hf = lane >> 5;
    const int t0 = (tid >> 4) * 4, cc = (tid & 15) * 4, row0 = c * 128 + t0;
    if (wave < 3) {
        const int h = 3 * g + wave; const float A = -__expf(a_log[h]), bias = dt_bias[h];
        const int s0 = 2 * lane, s1 = s0 + 1;
        const float dt0 = softplus(DT[(c * 128 + s0) * 8 + h] + bias), dt1 = softplus(DT[(c * 128 + s1) * 8 + h] + bias);
        const float x0 = dt0 * A, x1 = x0 + dt1 * A;
        float incl = x1;
#pragma unroll
        for (int o = 1; o < 64; o <<= 1) { const float y = __shfl_up(incl, o); if (lane >= o) incl += y; }
        const float excl = incl - x1;
        av[wave * 128 + s0] = excl + x0; av[wave * 128 + s1] = excl + x1; dtv[wave * 128 + s0] = dt0; dtv[wave * 128 + s1] = dt1;
        ACUM[(c * 128 + s0) * 8 + h] = excl + x0; ACUM[(c * 128 + s1) * 8 + h] = excl + x1;
        if (lane == 63) DEC[c * 8 + h] = __expf(incl);
    }
    {
        float o[4][4];
        conv4x4(XBC, row0, 384 + 64 * g + cc, cw, cb, o);
#pragma unroll
        for (int tt = 0; tt < 4; ++tt) *(u32x2*)(Bs + (t0 + tt) * 72 + cc) = pk4(o[tt][0], o[tt][1], o[tt][2], o[tt][3]);
#pragma unroll
        for (int j = 0; j < 4; ++j) *(u32x2*)(BT + (cc + j) * 136 + t0) = pk4(o[0][j], o[1][j], o[2][j], o[3][j]);
        conv4x4(XBC, row0, 512 + 64 * g + cc, cw, cb, o);
#pragma unroll
        for (int tt = 0; tt < 4; ++tt) { const u32x2 v = pk4(o[tt][0], o[tt][1], o[tt][2], o[tt][3]); *(u32x2*)(Cs + (t0 + tt) * 72 + cc) = v; *(u32x2*)(CC + (size_t)(row0 + tt) * 128 + 64 * g + cc) = v; }
    }
    __syncthreads();
    const int tb = wave >> 1, sb0 = 2 * (wave & 1);
    f32x16 cbm[2];
#pragma unroll
    for (int i = 0; i < 16; ++i) { cbm[0][i] = 0.f; cbm[1][i] = 0.f; }
    const int tbu = __builtin_amdgcn_readfirstlane(tb), sbu = __builtin_amdgcn_readfirstlane(sb0);
    if (sbu <= tbu) mm32(cbm[0], Cs + tb * 32 * 72, 72, Bs + sb0 * 32 * 72, 72, 4, lane);
    if (sbu + 1 <= tbu) mm32(cbm[1], Cs + tb * 32 * 72, 72, Bs + (sb0 + 1) * 32 * 72, 72, 4, lane);
#pragma unroll 1
    for (int hh = 0; hh < 3; ++hh) {
        const int h = 3 * g + hh;
        {
            float o[4][4];
            conv4x4(XBC, row0, 64 * h + cc, cw, cb, o);
            float dte[4];
#pragma unroll
            for (int tt = 0; tt < 4; ++tt) dte[tt] = __expf(av[hh * 128 + 127] - av[hh * 128 + t0 + tt]) * dtv[hh * 128 + t0 + tt];
#pragma unroll
            for (int j = 0; j < 4; ++j) { *(u32x2*)(XT + (cc + j) * 136 + t0) = pk4(o[0][j], o[1][j], o[2][j], o[3][j]);
                *(u32x2*)(XS + (cc + j) * 136 + t0) = pk4(o[0][j] * dte[0], o[1][j] * dte[1], o[2][j] * dte[2], o[3][j] * dte[3]); }
        }
#pragma unroll
        for (int blk = 0; blk < 2; ++blk) {
            if (sbu + blk > tbu) continue;
            const int s = (sb0 + blk) * 32 + (lane & 31); const float as = av[hh * 128 + s], dts = dtv[hh * 128 + s];
#pragma unroll
            for (int i = 0; i < 16; ++i) { const int t_ = tb * 32 + crow(i, hf);
                float w = cbm[blk][i] * __builtin_amdgcn_exp2f(fminf(av[hh * 128 + t_] - as, 0.f) * 1.4426950408889634f) * dts;
                w = (s <= t_) ? w : 0.f;
                Wm[t_ * 136 + s] = f2bf(w); }
        }
        __syncthreads();
        {
            const int pb = wave & 1; f32x16 acc;
#pragma unroll
            for (int i = 0; i < 16; ++i) acc[i] = 0.f;
            mm32(acc, Wm + tb * 32 * 136, 136, XT + pb * 32 * 136, 136, 2 * (tbu + 1), lane);
            const int p = pb * 32 + (lane & 31); const float dsk = d_skip[h];
#pragma unroll
            for (int i = 0; i < 16; ++i) { const int t_ = tb * 32 + crow(i, hf); Y[(size_t)(c * 128 + t_) * 384 + h * 64 + p] = f2bf(acc[i] + bf2f(XT[p * 136 + t_]) * dsk); }
        }
        if (wave < 4) {
            const int pb = wave >> 1, nb = wave & 1; f32x16 acc;
#pragma unroll
            for (int i = 0; i < 16; ++i) acc[i] = 0.f;
            mm32(acc, XS + pb * 32 * 136, 136, BT + nb * 32 * 136, 136, 8, lane);
            const int n = nb * 32 + (lane & 31);
#pragma unroll
            for (int i = 0; i < 16; ++i) { const int p_ = pb * 32 + crow(i, hf); ST[((size_t)(c * 6 + h) * 64 + p_) * 64 + n] = acc[i]; }
        }
        __syncthreads();
    }
}

DI void gmlp_item(unsigned char* smem, int c, int h, const us* U, const us* V, const float* SSQ, const float* gv, const float* w_s, const float* b_s, us* mix) {
    us* Ws = (us*)smem; us* VTs = (us*)(smem + 34816);
    int tid_l = threadIdx.x; asm volatile("" : "+v"(tid_l));
    const int tid = tid_l, wave = tid >> 6, lane = tid & 63, hf = lane >> 5;
    const int t = tid >> 2, cq = (tid & 3) * 16, row = c * 128 + t;
    {
        const f32x4 a = *(const f32x4*)(SSQ + row * 32), b = *(const f32x4*)(SSQ + row * 32 + 4);
        const float rstd = rsqrtf((((a[0] + a[1]) + (a[2] + a[3])) + ((b[0] + b[1]) + (b[2] + b[3]))) * (1.f / 256.f) + EPS);
        float x[16]; ld16bf(V + (size_t)row * 256 + 64 * h + cq, x);
#pragma unroll
        for (int j = 0; j < 16; ++j) VTs[(cq + j) * 136 + t] = f2bf(x[j] * rstd * gv[64 * h + cq + j]);
        const int s0 = (tid & 3) * 32; const float* wr = w_s + ((size_t)h * 128 + t) * 128 + s0;
#pragma unroll
        for (int q = 0; q < 4; ++q) {
            const f32x4 w0 = *(const f32x4*)(wr + 8 * q), w1 = *(const f32x4*)(wr + 8 * q + 4); f32x4 m0, m1;
#pragma unroll
            for (int e = 0; e < 4; ++e) { m0[e] = (s0 + 8 * q + e <= t) ? w0[e] : 0.f; m1[e] = (s0 + 8 * q + 4 + e <= t) ? w1[e] : 0.f; }
            st_bf16x8(Ws + t * 136 + s0 + 8 * q, m0, m1);
        }
    }
    const int tb = wave >> 1, db = wave & 1, d = db * 32 + (lane & 31);
    float uv[16], bv[16];
#pragma unroll
    for (int i = 0; i < 16; ++i) { const int t_ = tb * 32 + crow(i, hf); uv[i] = bf2f(U[((size_t)c * 128 + t_) * 256 + 64 * h + d]); bv[i] = b_s[h * 128 + t_]; }
    __syncthreads();
    {
        f32x16 acc;
#pragma unroll
        for (int i = 0; i < 16; ++i) acc[i] = 0.f;
        mm32(acc, Ws + tb * 32 * 136, 136, VTs + db * 32 * 136, 136, 2 * (__builtin_amdgcn_readfirstlane(tb) + 1), lane);
#pragma unroll
        for (int i = 0; i < 16; ++i) { const int t_ = tb * 32 + crow(i, hf); const size_t r_ = (size_t)c * 128 + t_;
            mix[r_ * DM + 64 * h + d] = f2bf((acc[i] + bv[i]) * uv[i]); }
    }
    __syncthreads();
}

DI void ssd_final_item(unsigned char* smem, int c, int g, const us* CC, const float* ST, const us* Y, const float* ACUM, const us* ZS, const float* ng, us* mix) {
    us* Cs = (us*)smem; us* HP = (us*)(smem + 18432); float* YG = (float*)(smem + 27648);
    int tid_l = threadIdx.x; asm volatile("" : "+v"(tid_l));
    const int tid = tid_l, wave = tid >> 6, lane = tid & 63, hf = lane >> 5;
    const int t = tid >> 2, cq = (tid & 3) * 16;
    const int hp_p = tid >> 3, hp_n0 = (tid & 7) * 8;
    const int tb = wave >> 1, pb = wave & 1, p = pb * 32 + (lane & 31);
    f32x4 h0, h1;
    { const float* src = ST + ((size_t)(c * 6 + 3 * g) * 64 + hp_p) * 64 + hp_n0; h0 = *(const f32x4*)src; h1 = *(const f32x4*)(src + 4); }
    { const us* src = CC + (size_t)(c * 128 + t) * 128 + 64 * g + cq; *(u32x4*)(Cs + t * 72 + cq) = *(const u32x4*)src; *(u32x4*)(Cs + t * 72 + cq + 8) = *(const u32x4*)(src + 8); }
#pragma unroll 1
    for (int hh = 0; hh < 3; ++hh) {
        const int h = 3 * g + hh;
        st_bf16x8(HP + hp_p * 72 + hp_n0, h0, h1);
        if (hh < 2) { const float* src = ST + ((size_t)(c * 6 + h + 1) * 64 + hp_p) * 64 + hp_n0; h0 = *(const f32x4*)src; h1 = *(const f32x4*)(src + 4); }
        float yv[16], av[16], zv[16];
#pragma unroll
        for (int i = 0; i < 16; ++i) { const size_t r_ = (size_t)c * 128 + tb * 32 + crow(i, hf);
            yv[i] = bf2f(Y[r_ * 384 + h * 64 + p]); av[i] = ACUM[r_ * 8 + h]; zv[i] = bf2f(ZS[r_ * 384 + h * 64 + p]); }
        __syncthreads();
        {
            f32x16 acc;
#pragma unroll
            for (int i = 0; i < 16; ++i) acc[i] = 0.f;
            mm32(acc, Cs + tb * 32 * 72, 72, HP + pb * 32 * 72, 72, 4, lane);
#pragma unroll
            for (int i = 0; i < 16; ++i) { const int t_ = tb * 32 + crow(i, hf);
                YG[t_ * 196 + hh * 64 + p] = (yv[i] + __expf(av[i]) * acc[i]) * zv[i]; }
        }
        __syncthreads();
    }
    {
        const int part = tid & 3; const float* yr = YG + t * 196 + part * 48; float v[48]; float ss = 0.f;
#pragma unroll
        for (int q = 0; q < 12; ++q) { const f32x4 a = *(const f32x4*)(yr + 4 * q); v[4 * q] = a[0]; v[4 * q + 1] = a[1]; v[4 * q + 2] = a[2]; v[4 * q + 3] = a[3]; ss += (a[0] * a[0] + a[1] * a[1]) + (a[2] * a[2] + a[3] * a[3]); }
        ss += __shfl_xor(ss, 1); ss += __shfl_xor(ss, 2);
        const float rstd = rsqrtf(ss * (1.f / 192.f) + EPS);
        const float* gp = ng + 192 * g + part * 48; us* dst = mix + (size_t)(c * 128 + t) * DM + 256 + 192 * g + part * 48;
#pragma unroll
        for (int q = 0; q < 6; ++q) { f32x4 a, b;
#pragma unroll
            for (int e = 0; e < 4; ++e) { a[e] = v[8 * q + e] * rstd * gp[8 * q + e]; b[e] = v[8 * q + 4 + e] * rstd * gp[8 * q + 4 + e]; }
            st_bf16x8(dst + 8 * q, a, b); }
    }
    __syncthreads();
}

constexpr int ATT_NQB = 64, ATT_ITEMS = 960;
DI int att_slot(int h, int qb, int kc) { const int g = qb >> 4, b = qb & 15; const int base = (g == 1) ? 2 * b : (g == 2) ? 32 + 3 * b : 80 + 4 * b; return h * 144 + base + kc; }
DI size_t att_slot_off(int slot) { return (size_t)slot * 16384; }
DI void att_decode(int u, int& h, int& qb, int& kc) {
    if (u < 576) { h = u % 6; const int v = u / 6;
        if (v < 16) { qb = 16 + v; kc = 0; } else if (v < 48) { const int w = v - 16; qb = 32 + (w >> 1); kc = w & 1; } else { const int w = v - 48; qb = 48 + w / 3; kc = w % 3; }
    } else { const int d = u - 576; h = d % 6; const int e = d / 6, q = e & 3; qb = 16 * q + 15 - (e >> 2); kc = q; }
}
constexpr int AT_KB = 64 * 208, AT_VB = 64 * 144;
DI void attn_unit(unsigned char* smem, const us* Q, const us* K, const us* VT, us* mix, us* PO, float* PML, int h, int qb, int kc) {
    int tid_l = threadIdx.x; asm volatile("" : "+v"(tid_l));
    const int tid = tid_l, wave = tid >> 6, lane = tid & 63, r = lane & 31, hf = lane >> 5;
    const int q0 = qb * 256 + wave * 32, qrow = q0 + r;
    bf16x8 qf[6];
#pragma unroll
    for (int ks = 0; ks < 6; ++ks) qf[ks] = *(const bf16x8*)(Q + ((size_t)h * M + qrow) * 96 + 16 * ks + 8 * hf);
    f32x16 o0, o1;
#pragma unroll
    for (int i = 0; i < 16; ++i) { o0[i] = 0.f; o1[i] = 0.f; }
    float mrun = -1e30f, lrun = 0.f;
    const int t0 = 64 * kc, tend = (64 * (kc + 1) < 4 * (qb + 1)) ? 64 * (kc + 1) : 4 * (qb + 1), ntiles = tend - t0, tg = __builtin_amdgcn_readfirstlane(q0 >> 6);
    const bool masked = tg < tend; const int tlw = (masked ? tg : tend - 1) - t0;
    const int id1 = 512 + (tid & 255);
    const int kg0 = tid * 8, kl0 = (tid / 12) * 104 + (tid % 12) * 8, kg1 = id1 * 8, kl1 = (id1 / 12) * 104 + (id1 % 12) * 8;
    const int vl0 = (tid >> 3) * 72 + ((tid & 7) >> 1) * 16 + (tid & 1) * 4;
    const us* Kg = K + (size_t)h * M * 96; const us* Vg = VT + (size_t)(h * 64 + (tid >> 3)) * M + (tid & 7) * 8;
    us* Kb0 = (us*)smem; us* Kb1 = (us*)(smem + AT_KB); us* Vb0 = (us*)(smem + 2 * AT_KB); us* Vb1 = (us*)(smem + 2 * AT_KB + AT_VB);
    u32x4 ka0, ka1, va, kb0, kb1, vb;
#define AT_LDK(R0, R1, t) do { const size_t kn_ = (size_t)(t0 + ((t) < ntiles ? (t) : ntiles - 1)) * 64; R0 = *(const u32x4*)(Kg + kn_ * 96 + kg0); R1 = *(const u32x4*)(Kg + kn_ * 96 + kg1); } while (0)
#define AT_LDV(R, t) do { const size_t kn_ = (size_t)(t0 + ((t) < ntiles ? (t) : ntiles - 1)) * 64; R = *(const u32x4*)(Vg + kn_); } while (0)
#define AT_STK(R0, R1, Kb) do { *(u32x4*)((Kb) + kl0) = R0; *(u32x4*)((Kb) + kl1) = R1; } while (0)
#define AT_STV(R, Vb) do { *(u32x2*)((Vb) + vl0) = (u32x2){R.x, R.y}; *(u32x2*)((Vb) + vl0 + 8) = (u32x2){R.z, R.w}; } while (0)
#define AT_QK(S0, S1, Kb) do { \
        _Pragma("unroll") for (int i = 0; i < 16; ++i) { S0[i] = 0.f; S1[i] = 0.f; } \
        _Pragma("unroll") for (int ks = 0; ks < 6; ++ks) { \
            const bf16x8 a0 = *(const bf16x8*)((Kb) + r * 104 + 16 * ks + 8 * hf), a1 = *(const bf16x8*)((Kb) + (32 + r) * 104 + 16 * ks + 8 * hf); \
            S0 = MFMA32(a0, qf[ks], S0); S1 = MFMA32(a1, qf[ks], S1); } } while (0)
#define AT_MASK(S0, S1, kbase) do { \
        _Pragma("unroll") for (int i = 0; i < 16; ++i) { const int key = (kbase) + crow(i, hf); if (key > qrow) S0[i] = -1e30f; if (key + 32 > qrow) S1[i] = -1e30f; } } while (0)
#define AT_SMPV(S0, S1, Vb) do { \
        float mx = fmaxf(S0[0], S1[0]); \
        _Pragma("unroll") for (int i = 1; i < 16; ++i) mx = fmaxf(mx, fmaxf(S0[i], S1[i])); \
        mx = fmaxf(mx, __shfl_xor(mx, 32)); \
        const float mnew = fmaxf(mrun, mx), alpha = __builtin_amdgcn_exp2f(mrun - mnew); \
        float rs = 0.f; \
        _Pragma("unroll") for (int i = 0; i < 16; ++i) { S0[i] = __builtin_amdgcn_exp2f(S0[i] - mnew); S1[i] = __builtin_amdgcn_exp2f(S1[i] - mnew); rs += S0[i] + S1[i]; } \
        rs += __shfl_xor(rs, 32); \
        lrun = lrun * alpha + rs; mrun = mnew; \
        if (__builtin_amdgcn_ballot_w64(alpha != 1.0f)) { _Pragma("unroll") for (int i = 0; i < 16; ++i) { o0[i] *= alpha; o1[i] *= alpha; } } \
        _Pragma("unroll") for (int j4 = 0; j4 < 4; ++j4) { \
            const int kb = j4 >> 1, s_ = j4 & 1; u32x4 pw; \
            if (kb == 0) { pw.x = pk2(S0[8 * s_], S0[8 * s_ + 1]); pw.y = pk2(S0[8 * s_ + 2], S0[8 * s_ + 3]); pw.z = pk2(S0[8 * s_ + 4], S0[8 * s_ + 5]); pw.w = pk2(S0[8 * s_ + 6], S0[8 * s_ + 7]); } \
            else         { pw.x = pk2(S1[8 * s_], S1[8 * s_ + 1]); pw.y = pk2(S1[8 * s_ + 2], S1[8 * s_ + 3]); pw.z = pk2(S1[8 * s_ + 4], S1[8 * s_ + 5]); pw.w = pk2(S1[8 * s_ + 6], S1[8 * s_ + 7]); } \
            const bf16x8 pf = __builtin_bit_cast(bf16x8, pw); \
            const int koff = kb * 32 + 16 * s_ + 8 * hf; \
            const bf16x8 a0 = *(const bf16x8*)((Vb) + r * 72 + koff), a1 = *(const bf16x8*)((Vb) + (32 + r) * 72 + koff); \
            o0 = MFMA32(a0, pf, o0); o1 = MFMA32(a1, pf, o1); } } while (0)
    AT_LDK(ka0, ka1, 0); AT_LDV(va, 0); AT_STK(ka0, ka1, Kb0); AT_STV(va, Vb0);
    AT_LDK(ka0, ka1, 1); AT_STK(ka0, ka1, Kb1);
    AT_LDK(kb0, kb1, 2); AT_LDV(vb, 1);
    __syncthreads();
    f32x16 sa0, sa1, sb0, sb1;
    AT_QK(sa0, sa1, Kb0);
    __syncthreads();
    int t = 0;
#define AT_EVEN_TAIL() do { AT_STK(kb0, kb1, Kb0); AT_STV(vb, Vb1); __syncthreads(); } while (0)
#define AT_ODD_TAIL() do { AT_STK(ka0, ka1, Kb1); AT_STV(va, Vb0); __syncthreads(); } while (0)
#pragma unroll 1
    for (; t + 1 < tlw; t += 2) {
        AT_LDK(ka0, ka1, t + 3); AT_LDV(va, t + 2);
        AT_QK(sb0, sb1, Kb1);
        AT_SMPV(sa0, sa1, Vb0);
        AT_EVEN_TAIL();
        AT_LDK(kb0, kb1, t + 4); AT_LDV(vb, t + 3);
        AT_QK(sa0, sa1, Kb0);
        AT_SMPV(sb0, sb1, Vb1);
        AT_ODD_TAIL();
    }
    if (t < tlw) {
        AT_LDK(ka0, ka1, t + 3); AT_LDV(va, t + 2);
        AT_QK(sb0, sb1, Kb1);
        AT_SMPV(sa0, sa1, Vb0);
        AT_EVEN_TAIL();
        ++t;
        AT_LDK(kb0, kb1, t + 3); AT_LDV(vb, t + 2);
        if (masked) AT_MASK(sb0, sb1, (t0 + t) * 64);
        AT_SMPV(sb0, sb1, Vb1);
        AT_ODD_TAIL();
        ++t;
    } else {
        AT_LDK(ka0, ka1, t + 3); AT_LDV(va, t + 2);
        if (masked) AT_MASK(sa0, sa1, (t0 + t) * 64);
        AT_SMPV(sa0, sa1, Vb0);
        AT_EVEN_TAIL();
        ++t;
    }
#pragma unroll 1
    for (; t < ntiles; ++t) {
        if (t & 1) { AT_LDK(kb0, kb1, t + 3); AT_LDV(vb, t + 2); AT_ODD_TAIL(); } else { AT_LDK(ka0, ka1, t + 3); AT_LDV(va, t + 2); AT_EVEN_TAIL(); }
    }
#undef AT_EVEN_TAIL
#undef AT_ODD_TAIL
#undef AT_LDK
#undef AT_LDV
#undef AT_STK
#undef AT_STV
#undef AT_QK
#undef AT_MASK
#undef AT_SMPV
    if (qb < 16) {
        const float inv = 1.f / lrun;
        us* dst = mix + (size_t)qrow * DM + 640 + h * 64;
#pragma unroll
        for (int gq = 0; gq < 4; ++gq) {
            u32x2 w0, w1;
            w0.x = pk2(o0[4 * gq] * inv, o0[4 * gq + 1] * inv); w0.y = pk2(o0[4 * gq + 2] * inv, o0[4 * gq + 3] * inv);
            w1.x = pk2(o1[4 * gq] * inv, o1[4 * gq + 1] * inv); w1.y = pk2(o1[4 * gq + 2] * inv, o1[4 * gq + 3] * inv);
            *(u32x2*)(dst + 8 * gq + 4 * hf) = w0; *(u32x2*)(dst + 32 + 8 * gq + 4 * hf) = w1;
        }
    } else {
        const int slot = att_slot(h, qb, kc), rowl = wave * 32 + r;
        us* po = PO + att_slot_off(slot) + (size_t)rowl * 64;
#pragma unroll
        for (int gq = 0; gq < 4; ++gq) {
            u32x2 w0, w1;
            w0.x = pk2(o0[4 * gq], o0[4 * gq + 1]); w0.y = pk2(o0[4 * gq + 2], o0[4 * gq + 3]);
            w1.x = pk2(o1[4 * gq], o1[4 * gq + 1]); w1.y = pk2(o1[4 * gq + 2], o1[4 * gq + 3]);
            *(u32x2*)(po + 8 * gq + 4 * hf) = w0; *(u32x2*)(po + 32 + 8 * gq + 4 * hf) = w1;
        }
        if (hf == 0) { PML[((size_t)slot * 256 + rowl) * 2] = mrun; PML[((size_t)slot * 256 + rowl) * 2 + 1] = lrun; }
    }
}
DI void attn_merge(const us* PO, const float* PML, us* mix, int h, int qb) {
    int tid = threadIdx.x; asm volatile("" : "+v"(tid));
    const int row = tid >> 1, c0 = (tid & 1) * 32, nch = (qb >> 4) + 1;
    float mk[4], lk[4], M_ = -1e30f;
#pragma unroll
    for (int k = 0; k < 4; ++k) if (k < nch) { const size_t ix = ((size_t)att_slot(h, qb, k) * 256 + row) * 2; mk[k] = PML[ix]; lk[k] = PML[ix + 1]; M_ = fmaxf(M_, mk[k]); }
    float L = 0.f, wk[4];
#pragma unroll
    for (int k = 0; k < 4; ++k) if (k < nch) { wk[k] = __builtin_amdgcn_exp2f(mk[k] - M_); L += wk[k] * lk[k]; }
    const float inv = 1.f / L;
    f32x4 acc[8];
#pragma unroll
    for (int j = 0; j < 8; ++j) acc[j] = (f32x4){0.f, 0.f, 0.f, 0.f};
#pragma unroll
    for (int k = 0; k < 4; ++k) if (k < nch) { const us* po = PO + att_slot_off(att_slot(h, qb, k)) + (size_t)row * 64 + c0; const float w = wk[k] * inv;
#pragma unroll
        for (int j = 0; j < 4; ++j) { const u32x4 v = *(const u32x4*)(po + 8 * j);
            acc[2 * j] += (f32x4){__uint_as_float(v.x << 16), __uint_as_float(v.x & 0xffff0000u), __uint_as_float(v.y << 16), __uint_as_float(v.y & 0xffff0000u)} * w;
            acc[2 * j + 1] += (f32x4){__uint_as_float(v.z << 16), __uint_as_float(v.z & 0xffff0000u), __uint_as_float(v.w << 16), __uint_as_float(v.w & 0xffff0000u)} * w; } }
    us* dst = mix + (size_t)(qb * 256 + row) * DM + 640 + h * 64 + c0;
#pragma unroll
    for (int j = 0; j < 4; ++j) st_bf16x8(dst + 8 * j, acc[2 * j], acc[2 * j + 1]);
}
DI const void* ldp_g(const unsigned char* lds, int i, const unsigned char* gbase) {
    const volatile unsigned* t = (const volatile unsigned*)(lds + 131328) + 2 * i;
    const unsigned lo = __builtin_amdgcn_readfirstlane(t[0]), hi = __builtin_amdgcn_readfirstlane(t[1]);
    const long long off = (long long)((((unsigned long long)hi << 32) | lo) - (unsigned long long)gbase);
    return (const void*)(gbase + off);
}
#define LAS __attribute__((address_space(3)))
#define XB_TMO      128
#define XB_XCNT(j)  (256  + 64 * (j))
#define XB_XSUB(j)  (1280 + 64 * (j))
#define XB_XGEN(j)  (2304 + 64 * (j))
#define XB_TOP      3328
#define XB_TOPGEN   3392
#define XCD_BAR_WORDS 3456
#define XB_SPIN_CAP (1u << 18)

__device__ __forceinline__ unsigned xb_ld(unsigned* p)              { return __hip_atomic_load(p, __ATOMIC_RELAXED, __HIP_MEMORY_SCOPE_AGENT); }
__device__ __forceinline__ unsigned xb_add(unsigned* p, unsigned v) { return __hip_atomic_fetch_add(p, v, __ATOMIC_RELAXED, __HIP_MEMORY_SCOPE_AGENT); }
__device__ __forceinline__ unsigned xb_xcc_id() { return (unsigned)__builtin_amdgcn_s_getreg((3 << 11) | 20) & 0xFu; }
#define XB_SPIN(cond, bar) do { unsigned _sp = 0; while (cond) { __builtin_amdgcn_s_sleep(1); \
    if ((++_sp & 255u) == 0u) { if (xb_ld(&(bar)[XB_TMO])) break; if (_sp > XB_SPIN_CAP) { atomicAdd(&(bar)[XB_TMO], 1u); break; } } } } while (0)

struct XcdBarrier {
    unsigned* bar; unsigned x;
    volatile LAS unsigned* st;
};

__device__ __forceinline__ XcdBarrier xcd_barrier_post(unsigned* bar, volatile LAS unsigned* st) {
    XcdBarrier b; b.bar = bar; b.x = xb_xcc_id(); b.st = st;
    if (threadIdx.x == 0) (void)xb_add(&bar[XB_XCNT(b.x)], 1u);
    return b;
}
__device__ __forceinline__ void xcd_barrier_complete(unsigned* bar, unsigned x, unsigned& nloc, unsigned& nx) {
    const unsigned G = gridDim.x * gridDim.y * gridDim.z;
    unsigned sum, cnt, mine, sp = 0u;
    for (;;) {
        sum = 0u; cnt = 0u; mine = 0u;
#pragma unroll
        for (unsigned j = 0; j < 16; ++j) { const unsigned c = xb_ld(&bar[XB_XCNT(j)]); sum += c; cnt += (c > 0u) ? 1u : 0u; mine = (j == x) ? c : mine; }
        if (sum == G) break;
        __builtin_amdgcn_s_sleep(1);
        if ((++sp & 255u) == 0u) { if (xb_ld(&bar[XB_TMO])) break; if (sp > XB_SPIN_CAP) { atomicAdd(&bar[XB_TMO], 1u); break; } }
    }
    nloc = mine > 0u ? mine : 1u; nx = cnt > 0u ? cnt : 1u;
}

__device__ __forceinline__ void xcd_barrier(const XcdBarrier& b) {
    asm volatile("s_waitcnt vmcnt(0)" ::: "memory");
    __syncthreads();
    if (threadIdx.x == 0) {
        unsigned* bar = b.bar;
        __builtin_amdgcn_s_waitcnt(0);
        unsigned nloc = b.st[0], nx = b.st[1];
        if (nloc == 0u) { xcd_barrier_complete(bar, b.x, nloc, nx); b.st[0] = nloc; b.st[1] = nx; }
        const unsigned old = xb_add(&bar[XB_XSUB(b.x)], 1u);
        const unsigned gen = old / nloc;
        if (old + 1u == (gen + 1u) * nloc) {
            __builtin_amdgcn_fence(__ATOMIC_RELEASE, "agent");
            asm volatile("s_waitcnt vmcnt(0)" ::: "memory");
            const unsigned og = xb_add(&bar[XB_TOP], 1u);
            const unsigned tg = og / nx;
            if (og + 1u == (tg + 1u) * nx) xb_add(&bar[XB_TOPGEN], 1u);
            else XB_SPIN(xb_ld(&bar[XB_TOPGEN]) == tg, bar);
            __builtin_amdgcn_fence(__ATOMIC_ACQUIRE, "agent");
            xb_add(&bar[XB_XGEN(b.x)], 1u);
            asm volatile("s_waitcnt vmcnt(0)" ::: "memory");
        } else {
            XB_SPIN(xb_ld(&bar[XB_XGEN(b.x)]) == gen, bar);
            __builtin_amdgcn_fence(__ATOMIC_ACQUIRE, "agent");
            asm volatile("s_waitcnt vmcnt(0)" ::: "memory");
        }
    }
    __syncthreads();
}
constexpr int NTHR = 512;
#define XB_ST_OFF 131136
#define GSYNC() do { XcdBarrier xb_; xb_.bar = (unsigned*)(WSP + WS_CTL) + 1024; xb_.x = xb_xcc_id(); xb_.st = (volatile LAS unsigned*)(glds + XB_ST_OFF); xcd_barrier(xb_); } while (0)
#define INP(i) ((const float*)ldp_g(lds, (i), gbase))
#define OUTP ((float*)ldp_g(lds, 21, gbase))
#define WSP ((unsigned char*)ldp_g(lds, 22, gbase))

DI void conv_list_a(unsigned char* lds, const unsigned char* gbase, unsigned char* ws, int l, int wo_buf, int w0, int nw, int wave, int lane) {
    float* scr = (float*)(lds + wave * 8448);
    const float* w_in = INP(2) + (size_t)l * DM * DIN; const float* w_qb = INP(13) + (size_t)l * 384 * 576; const float* w_kvb = INP(15) + (size_t)l * 256 * 768; const float* w_out = INP(16) + (size_t)l * DM * DM;
    const float* g1 = INP(1) + l * DM; const float* gq = INP(12) + l * 384; const float* gkv = INP(14) + l * 256;
    us* Win_t = (us*)(ws + WS_WIN); us* Wqb_t = (us*)(ws + WS_WQB); us* Wkn_t = (us*)(ws + WS_WKN); us* Wv_t = (us*)(ws + WS_WV); us* Wout_t = (us*)(ws + (wo_buf ? WS_WOUT2 : WS_WOUT));
    constexpr int I_IN = 16 * 72, I_QB = 6 * 24, I_KN = 4 * 16, I_V = 4 * 16, I_OUT = 16 * 32, NIT = I_IN + I_QB + I_KN + I_V + I_OUT;
    for (int it = w0; it < NIT; it += nw) {
        int r = it;
        if (r < I_IN) { tr_item<1>(w_in, DM, DIN, Win_t, g1, scr, r, 72, lane); continue; } r -= I_IN;
        if (r < I_QB) { tr_item<2>(w_qb, 384, 576, Wqb_t, gq, scr, r, 24, lane); continue; } r -= I_QB;
        if (r < I_KN) { tr_item<3>(w_kvb, 256, 768, Wkn_t, gkv, scr, r, 16, lane); continue; } r -= I_KN;
        if (r < I_V) { tr_item<4>(w_kvb, 256, 768, Wv_t, gkv, scr, r, 16, lane); continue; } r -= I_V;
        tr_item<0>(w_out, DM, DM, Wout_t, nullptr, scr, r, 32, lane);
    }
}
DI void conv_list_b(unsigned char* lds, const unsigned char* gbase, unsigned char* ws, int l, int w0, int nw, int wave, int lane) {
    float* scr = (float*)(lds + wave * 8448);
    const float* w1 = INP(18) + (size_t)l * DM * FF; const float* w2 = INP(19) + (size_t)l * FF * DM; const float* g2 = INP(17) + l * DM;
    us* W1_t = (us*)(ws + WS_W1); us* W2_t = (us*)(ws + WS_W2);
    constexpr int I_1 = 16 * 128, I_2 = 64 * 32;
    for (int it = w0; it < I_1 + I_2; it += nw) {
        if (it < I_1) tr_item<0>(w1, DM, FF, W1_t, g2, scr, it, 128, lane);
        else tr_item<0>(w2, FF, DM, W2_t, nullptr, scr, it - I_1, 32, lane);
    }
}

__global__ void __launch_bounds__(NTHR, 2) fwd_megakernel(Params p) {
    extern __shared__ __attribute__((aligned(16))) unsigned char lds[];
    const int tid = threadIdx.x, lane = tid & 63, wave = __builtin_amdgcn_readfirstlane(tid >> 6);
    const int G = gridDim.x, bid = blockIdx.x, gw = bid * 8 + wave, NGW = G * 8;
    {
        unsigned long long* tab = (unsigned long long*)(lds + 131328);
        if (tid == 0) {
#pragma unroll
            for (int i = 0; i < 21; ++i) tab[i] = (unsigned long long)p.in[i];
            tab[21] = (unsigned long long)p.out; tab[22] = (unsigned long long)p.ws;
        }
        if (tid < 2) ((volatile unsigned*)(lds + XB_ST_OFF))[tid] = 0u;
        __syncthreads();
    }
    PG8_LAS unsigned char* glds = (PG8_LAS unsigned char*)lds;
    const unsigned char* gbase = p.ws;
    (void)xcd_barrier_post((unsigned*)(WSP + WS_CTL) + 1024, (volatile LAS unsigned*)(glds + XB_ST_OFF));

    {
        unsigned char* ws = WSP; float* ROPE = (float*)(ws + WS_ROPE);
        for (int idx = bid * NTHR + tid; idx < M * 16; idx += G * NTHR) {
            const int pos = idx >> 4, i = idx & 15;
            const float inv_freq = powf(10000.0f, -(float)i / 16.0f);
            const float ang = (float)pos * inv_freq;
            const double rev = (double)ang * 0.15915494309189535;
            const float fr = (float)(rev - rint(rev));
            ROPE[2 * idx] = __builtin_amdgcn_cosf(fr); ROPE[2 * idx + 1] = __builtin_amdgcn_sinf(fr);
        }
        conv_list_a(lds, gbase, ws, 0, 0, gw, NGW, wave, lane);
        x_to_bf16_ssq(INP(0), (us*)(ws + WS_XN), (float*)(ws + WS_SSQX), gw, NGW, lane);
    }
    if (gridDim.x == 0x7fffffffu) cg::this_grid().sync();
    GSYNC();

#pragma unroll 1
    for (int l = 0; l < NL; ++l) {
        {
            unsigned char* ws = WSP;
            pg8::Gemm g{(us*)(ws + WS_XN), (us*)(ws + WS_WIN), M, DINP, DM}; pg8::StaticOrder S; S.init(M, DINP, G, bid);
            EpiIn E{ws};
            prep_rstd(S, (const float*)(ws + WS_SSQX), (float*)(ws + WS_RSTD));
            pg8::gemm_phase<EpiIn, pg8::StaticOrder, true, true>(glds, g, S, E);
            __syncthreads();
            if (G > 64) { if (bid >= 64) conv_list_b(lds, gbase, ws, l, (bid - 64) * 8 + wave, (G - 64) * 8, wave, lane); }
            else conv_list_b(lds, gbase, ws, l, gw, NGW, wave, lane);
        }
        GSYNC();
        {
            unsigned char* ws = WSP;
            us* CQ = (us*)(ws + WS_CQ); us* CKV = (us*)(ws + WS_CKV); us* Q = (us*)(ws + WS_Q); us* K = (us*)(ws + WS_K); us* VT = (us*)(ws + WS_VT);
            float* SSQ = (float*)(ws + WS_SSQ); float* ROPE = (float*)(ws + WS_ROPE);
            { pg8::Gemm g{CQ, (us*)(ws + WS_WQB), M, 768, 384}; pg8::StaticOrder S; S.init(M, 768, G, bid); EpiQ E{Q, SSQ, ROPE}; pg8::gemm_phase<EpiQ, pg8::StaticOrder, true, true>(glds, g, S, E); }
            __syncthreads();
            { pg8::Gemm g{CKV, (us*)(ws + WS_WKN), M, 512, 256}; pg8::StaticOrder S; S.init(M, 512, G, (bid + 64) % G); EpiKn E{K, SSQ}; pg8::gemm_phase<EpiKn, pg8::StaticOrder, true, true>(glds, g, S, E); }
            __syncthreads();
            { pg8::Gemm g{(us*)(ws + WS_WV), CKV, 512, M, 256}; pg8::StaticOrder S; S.init(512, M, G, (bid + 192) % G); EpiVt E{VT, SSQ}; pg8::gemm_phase<EpiVt, pg8::StaticOrder, true, true>(glds, g, S, E); }
            __syncthreads();
            const float* cw = INP(6) + (size_t)l * 4 * 640; const float* cb = INP(7) + l * 640;
            for (int it = bid; it < 256; it += G)
                ssd_item(lds, it >> 1, it & 1, (us*)(ws + WS_XBC), (float*)(ws + WS_DT), cw, cb, INP(8) + l * 6, INP(9) + l * 6, INP(10) + l * 6,
                         (us*)OUTP  , (float*)(ws + WS_ST), (float*)(ws + WS_ACUM), (float*)(ws + WS_DEC), (us*)(ws + WS_CC));
            for (int it = bid; it < 512; it += G)
                gmlp_item(lds, it >> 2, it & 3, (us*)(ws + WS_U), (us*)(ws + WS_V), SSQ, INP(3) + l * 256, INP(4) + (size_t)l * 4 * 128 * 128, INP(5) + l * 4 * 128, (us*)(ws + WS_MIX));
        }
        GSYNC();
        {
            unsigned char* ws = WSP;
            float* ST = (float*)(ws + WS_ST); const float* DEC = (const float*)(ws + WS_DEC);
            int tl = threadIdx.x; asm volatile("" : "+v"(tl)); const int idx = bid * NTHR + tl;
            if (idx < 6 * 4096) {
                const int h = idx >> 12, pn = idx & 4095; float hs = 0.f;
#pragma unroll 1
                for (int c0 = 0; c0 < 128; c0 += 16) {
                    float tmp[16], dc[16];
#pragma unroll
                    for (int j = 0; j < 16; ++j) { tmp[j] = ST[((size_t)(c0 + j) * 6 + h) * 4096 + pn]; dc[j] = DEC[(c0 + j) * 8 + h]; }
#pragma unroll
                    for (int j = 0; j < 16; ++j) { ST[((size_t)(c0 + j) * 6 + h) * 4096 + pn] = hs; hs = dc[j] * hs + tmp[j]; }
                }
            }
            volatile unsigned* slot = (volatile unsigned*)(lds + 131200);
            {
            unsigned* qctr = (unsigned*)(ws + WS_CTL) + 64 * l;
            for (;;) {
                if (tid == 0) slot[0] = atomicAdd(qctr, 1u);
                __syncthreads();
                const unsigned uu = (unsigned)__builtin_amdgcn_readfirstlane((int)slot[0]);
                __syncthreads();
                if (uu >= (unsigned)ATT_ITEMS) break;
                int ah, aqb, akc; att_decode((int)uu, ah, aqb, akc);
                attn_unit(lds, (us*)(ws + WS_Q), (us*)(ws + WS_K), (us*)(ws + WS_VT), (us*)(ws + WS_MIX), (us*)(ws + 124 * MiB), (float*)(ws + 162 * MiB), ah, aqb, akc);
            }
            }
        }
        GSYNC();
        {
            unsigned char* ws = WSP;
            for (int it = bid; it < 288; it += G) attn_merge((const us*)(ws + 124 * MiB), (const float*)(ws + 162 * MiB), (us*)(ws + WS_MIX), it % 6, 16 + it / 6);
            for (int it = bid; it < 256; it += G)
                ssd_final_item(lds, it >> 1, it & 1, (us*)(ws + WS_CC), (float*)(ws + WS_ST), (us*)OUTP  , (float*)(ws + WS_ACUM), (us*)(ws + WS_ZS), INP(11) + l * 384, (us*)(ws + WS_MIX));
            if (l + 1 < NL) {
                if (G > 32) { if (bid >= 32) conv_list_a(lds, gbase, ws, l + 1, (l + 1) & 1, (bid - 32) * 8 + wave, (G - 32) * 8, wave, lane); }
                else conv_list_a(lds, gbase, ws, l + 1, (l + 1) & 1, gw, NGW, wave, lane);
            }
        }
        GSYNC();
        {
            unsigned char* ws = WSP;
            pg8::Gemm g{(us*)(ws + WS_MIX), (us*)(ws + ((l & 1) ? WS_WOUT2 : WS_WOUT)), M, DM, DM}; pg8::StaticOrder S; S.init(M, DM, G, bid);
            EpiRes E{(us*)(ws + WS_XN), (float*)(ws + WS_SSQX)};
            pg8::gemm_phase<EpiRes, pg8::StaticOrder, true, true>(glds, g, S, E);
        }
        GSYNC();
        {
            unsigned char* ws = WSP;
            pg8::Gemm g{(us*)(ws + WS_XN), (us*)(ws + WS_W1), M, FF, DM}; pg8::StaticOrder S; S.init(M, FF, G, bid); EpiRelu2 E{(us*)(ws + WS_H), (const float*)(ws + WS_RSTD)};
            prep_rstd(S, (const float*)(ws + WS_SSQX), (float*)(ws + WS_RSTD));
            pg8::gemm_phase<EpiRelu2, pg8::StaticOrder, true, true>(glds, g, S, E);
        }
        GSYNC();
        {
            unsigned char* ws = WSP;
            pg8::Gemm g{(us*)(ws + WS_H), (us*)(ws + WS_W2), M, DM, FF}; pg8::StaticOrder S; S.init(M, DM, G, bid);
            EpiRes E{(us*)(ws + WS_XN), (float*)(ws + WS_SSQX)};
            pg8::gemm_phase<EpiRes, pg8::StaticOrder, true, true>(glds, g, S, E);
        }
        GSYNC();
    }
    norm_rows_out((const us*)(WSP + WS_XN), OUTP, INP(20), gw, NGW, lane);
}

extern "C" void kernel_launch(void* const* d_in, const int* in_sizes, int n_in, void* d_out, int out_size, void* d_ws, size_t ws_size, hipStream_t stream) {
    static int grid = 0;
    if (grid == 0) {
        if (n_in != 21 || out_size != M * DM || ws_size < WS_END) { fprintf(stderr, "kernel_launch: unexpected shapes (n_in %d out %d ws %zu)\n", n_in, out_size, ws_size); grid = -1; return; }
        int dev = 0, cus = 0, per_cu = 0;
        (void)hipGetDevice(&dev); (void)hipDeviceGetAttribute(&cus, hipDeviceAttributeMultiprocessorCount, dev);
        (void)hipFuncSetAttribute((const void*)fwd_megakernel, hipFuncAttributeMaxDynamicSharedMemorySize, LDS_BYTES);
        (void)hipOccupancyMaxActiveBlocksPerMultiprocessor(&per_cu, (const void*)fwd_megakernel, NTHR, LDS_BYTES);
        if (per_cu < 1) { fprintf(stderr, "kernel_launch: occupancy query says %d blocks per CU\n", per_cu); per_cu = 1; }
        (void)hipGetLastError();
        grid = cus * per_cu;
    }
    if (grid < 0) return;
    (void)hipMemsetAsync((char*)d_ws + WS_CTL, 0, 32768, stream);
    Params p{};
    for (int i = 0; i < 21; ++i) p.in[i] = (const float*)d_in[i];
    p.out = (float*)d_out; p.ws = (unsigned char*)d_ws;
    void* args[] = {&p};
    hipError_t e = hipLaunchCooperativeKernel((const void*)fwd_megakernel, dim3(grid), dim3(NTHR), args, LDS_BYTES, stream);
    if (e != hipSuccess) fprintf(stderr, "cooperative launch failed: %s (grid %d)\n", hipGetErrorString(e), grid);
}
```

```cpp
#include <hip/hip_runtime.h>
#include <hip/hip_cooperative_groups.h>
#include <cstdio>
#include <cstdint>
namespace cg = cooperative_groups;
namespace pg8 {
#define PG8_LAS __attribute__((address_space(3)))
typedef unsigned short bf16_t;
typedef short bf16x8 __attribute__((ext_vector_type(8)));
typedef float f32x4 __attribute__((ext_vector_type(4)));
typedef unsigned u32x4 __attribute__((ext_vector_type(4)));
constexpr int BM = 256, BK = 64, HALF = 128, HTB = HALF * BK * 2  , STAGE_BYTES = 8 * HTB, NXCD = 8, WGM = 8;

__host__ __device__ __forceinline__ int lds_byte(int r, int c) { const int st = (r >> 4) * 2 + (c >> 5), rr = r & 15, cc = c & 31, ob = rr * 64 + cc * 2; return st * 1024 + (ob ^ (((ob >> 9) & 1) << 5)); }
__host__ __device__ __forceinline__ void stage_rc(int b, int& R, int& C) { const int st = b / 1024, sb = b % 1024, swz = sb ^ (((sb >> 9) & 1) << 5); R = (st >> 1) * 16 + swz / 64; C = (st & 1) * 32 + (swz % 64) / 2; }
__host__ __device__ __forceinline__ int perm32(int rho) { const int n = rho >> 4, i = rho & 15; return 8 * (i >> 2) + 4 * n + (i & 3); }

struct Unit { int pm, pn; };
struct Gemm { const bf16_t* A; const bf16_t* Bt; int M, N, K; };

struct StaticOrder {
    int nM, nN, nwg, G, c;
    __host__ __device__ void init(int M, int N, int G_, int c_) { nM = M / BM; nN = N / BM; nwg = nM * nN; G = G_; c = c_; }
    __host__ __device__ bool next(int i, Unit& u) const {
        const long L = (long)i * G + c; if (L >= nwg) return false;
        int wgid = (int)L; { const int q = nwg / NXCD, r = nwg % NXCD, xcd = wgid % NXCD, off = wgid / NXCD; wgid = (xcd < r ? xcd * (q + 1) : r * (q + 1) + (xcd - r) * q) + off; }
        const int nig = WGM * nN, gid = wgid / nig, fm = gid * WGM, gsz = (nM - fm) < WGM ? (nM - fm) : WGM;
        u.pm = fm + ((wgid % nig) % gsz); u.pn = (wgid % nig) / gsz; return true;
    }
    __device__ __forceinline__ void a_ready(const Unit&) const {}
    __device__ __forceinline__ void done(const Unit&) const {}
};

__device__ __forceinline__ unsigned cvt_pk_bf16(float lo, float hi) { unsigned r; asm volatile("v_cvt_pk_bf16_f32 %0, %1, %2" : "=v"(r) : "v"(lo), "v"(hi)); return r; }
template <class Epi, class Sched, bool ALIGN_EPI = false, bool SP2 = false>
__device__ __forceinline__ void gemm_phase(PG8_LAS unsigned char* lds, const Gemm g, const Sched& S, const Epi& E) {
    int tid_l = threadIdx.x; asm volatile("" : "+v"(tid_l));
    const int tid = tid_l, wid = __builtin_amdgcn_readfirstlane(tid >> 6), lane = tid & 63, wr = wid >> 2, wc = wid & 3, fr = lane & 15, fq = lane >> 4;
    int K_l = g.K; asm volatile("" : "+s"(K_l));
    const int K = K_l, nt = K / BK;
    unsigned voffA[2], voffB[2];
#pragma unroll
    for (int i = 0; i < 2; ++i) { int R, C; stage_rc(tid * 16 + i * 8192, R, C); const int Rb = Epi::PERM ? ((R & ~31) + perm32(R & 31)) : R;
        voffA[i] = (unsigned)(R * K + C) * 2u; voffB[i] = (unsigned)(Rb * K + C) * 2u; }
    const size_t kstep = (size_t)(BK * 2);
    const size_t hstep = (size_t)HALF * K * 2;
    const size_t tstep = 2 * hstep;
    const unsigned ldsw = (unsigned)wid * 1024u;
    const int aoff = lds_byte(wr * 64 + fr, fq * 8), boff = lds_byte(wc * 32 + fr, fq * 8);
#define PG8_SA(b, h) (((b) * 2 + (h)) * HTB)
#define PG8_SB(b, h) ((4 + (b) * 2 + (h)) * HTB)
#define PG8_STAGE(bufoff, gbase, voff) do { _Pragma("unroll") for (int _i = 0; _i < 2; ++_i) \
        __builtin_amdgcn_global_load_lds((const unsigned*)((const char*)(gbase) + (voff)[_i]), (PG8_LAS unsigned*)(lds + (bufoff) + ldsw + _i * 8192), 16, 0, 0); } while (0)
#define PG8_LDA(dst, b, h) do { _Pragma("unroll") for (int m = 0; m < 4; ++m) _Pragma("unroll") for (int k = 0; k < 2; ++k) dst[m][k] = *(const PG8_LAS bf16x8*)(lds + PG8_SA(b, h) + aoff + m * 2048 + k * 1024); } while (0)
#define PG8_LDB(dst, b, h) do { _Pragma("unroll") for (int n = 0; n < 2; ++n) _Pragma("unroll") for (int k = 0; k < 2; ++k) dst[n][k] = *(const PG8_LAS bf16x8*)(lds + PG8_SB(b, h) + boff + n * 2048 + k * 1024); } while (0)
#define PG8_MMA(ai, bj, At, Bt) do { __builtin_amdgcn_s_setprio(1); _Pragma("unroll") for (int m = 0; m < 4; ++m) _Pragma("unroll") for (int n = 0; n < 2; ++n) _Pragma("unroll") for (int k = 0; k < 2; ++k) \
        acc[ai][bj][m][n] = __builtin_amdgcn_mfma_f32_16x16x32_bf16(Bt[n][k], At[m][k], acc[ai][bj][m][n], 0, 0, 0); __builtin_amdgcn_s_setprio(0); } while (0)
#define PG8_WAIT_V(n) asm volatile("s_waitcnt vmcnt(" #n ")" ::: "memory")
#define PG8_WAIT_L(n) asm volatile("s_waitcnt lgkmcnt(" #n ")" ::: "memory")
#define PG8_BAR __builtin_amdgcn_s_barrier()
#define PG8_SCHED __builtin_amdgcn_sched_barrier(0)
    Unit cur, nxt; int ui = 0;
    if (!S.next(0, cur)) return;
    f32x4 acc[2][2][4][2];
#pragma unroll
    for (int a = 0; a < 2; ++a)
#pragma unroll
        for (int b = 0; b < 2; ++b)
#pragma unroll
            for (int m = 0; m < 4; ++m)
#pragma unroll
                for (int n = 0; n < 2; ++n) acc[a][b][m][n] = (f32x4){0.f, 0.f, 0.f, 0.f};
    bf16x8 At[4][2], B0[2][2], B1[2][2];
    const char* cA = (const char*)g.A + (size_t)cur.pm * tstep; const char* cB = (const char*)g.Bt + (size_t)cur.pn * tstep;
    S.a_ready(cur);
    if constexpr (SP2) {
        PG8_STAGE(PG8_SB(0, 0), cB, voffB); PG8_STAGE(PG8_SB(0, 1), cB + hstep, voffB); PG8_STAGE(PG8_SA(0, 0), cA, voffA); PG8_STAGE(PG8_SA(0, 1), cA + hstep, voffA);
        if (wr == 1) PG8_BAR;
        PG8_WAIT_V(2); PG8_BAR;
        PG8_STAGE(PG8_SB(1, 0), cB + kstep, voffB); PG8_STAGE(PG8_SA(1, 0), cA + kstep, voffA); PG8_STAGE(PG8_SB(1, 1), cB + hstep + kstep, voffB);
        PG8_WAIT_V(6); PG8_BAR;
    } else {
        PG8_STAGE(PG8_SB(0, 0), cB, voffB); PG8_STAGE(PG8_SA(0, 0), cA, voffA); PG8_STAGE(PG8_SB(0, 1), cB + hstep, voffB); PG8_STAGE(PG8_SA(0, 1), cA + hstep, voffA);
        if (wr == 1) PG8_BAR;
        PG8_WAIT_V(4); PG8_BAR;
        PG8_STAGE(PG8_SB(1, 0), cB + kstep, voffB); PG8_STAGE(PG8_SA(1, 0), cA + kstep, voffA); PG8_STAGE(PG8_SB(1, 1), cB + hstep + kstep, voffB);
        PG8_WAIT_V(6); PG8_BAR;
    }
    for (;;) {
        const bool has_next = S.next(ui + 1, nxt);
        const char* nA = has_next ? (const char*)g.A + (size_t)nxt.pm * tstep : cA; const char* nB = has_next ? (const char*)g.Bt + (size_t)nxt.pn * tstep : cB;
        for (int t = 0; t < nt; t += 2) {
            const bool last = (t == nt - 2);
            const char* a1 = cA + (size_t)(t + 1) * kstep;
            const char* a2 = last ? nA : cA + (size_t)(t + 2) * kstep; const char* b2 = last ? nB : cB + (size_t)(t + 2) * kstep;
            const char* a3 = a2 + kstep; const char* b3 = b2 + kstep;
            if (last && has_next) S.a_ready(nxt);
            if constexpr (SP2) {
            PG8_LDB(B0, 0, 0); PG8_LDB(B1, 0, 1); PG8_SCHED; PG8_LDA(At, 0, 0); PG8_STAGE(PG8_SA(1, 1), a1 + hstep, voffA);
            PG8_WAIT_V(8); PG8_WAIT_L(0); PG8_BAR; PG8_MMA(0, 0, At, B0); PG8_MMA(0, 1, At, B1); PG8_BAR; PG8_SCHED;
            PG8_LDA(At, 0, 1); PG8_STAGE(PG8_SB(0, 0), b2, voffB); PG8_STAGE(PG8_SB(0, 1), b2 + hstep, voffB); PG8_STAGE(PG8_SA(0, 0), a2, voffA);
            PG8_WAIT_V(8); PG8_WAIT_L(0); PG8_BAR; PG8_MMA(1, 0, At, B0); PG8_MMA(1, 1, At, B1); PG8_BAR; PG8_SCHED;
            PG8_LDB(B0, 1, 0); PG8_LDB(B1, 1, 1); PG8_SCHED; PG8_LDA(At, 1, 0); PG8_STAGE(PG8_SA(0, 1), a2 + hstep, voffA);
            PG8_WAIT_V(8); PG8_WAIT_L(0); PG8_BAR; PG8_MMA(0, 0, At, B0); PG8_MMA(0, 1, At, B1); PG8_BAR; PG8_SCHED;
            PG8_LDA(At, 1, 1); PG8_STAGE(PG8_SB(1, 0), b3, voffB); PG8_STAGE(PG8_SB(1, 1), b3 + hstep, voffB); PG8_STAGE(PG8_SA(1, 0), a3, voffA);
            PG8_WAIT_V(8); PG8_WAIT_L(0); PG8_BAR; PG8_MMA(1, 0, At, B0); PG8_MMA(1, 1, At, B1); PG8_BAR; PG8_SCHED;
            } else {
            PG8_LDB(B0, 0, 0); PG8_SCHED; PG8_LDA(At, 0, 0); PG8_STAGE(PG8_SA(1, 1), a1 + hstep, voffA);
            PG8_WAIT_L(8); PG8_BAR; PG8_WAIT_L(0); PG8_MMA(0, 0, At, B0); PG8_BAR; PG8_SCHED;
            PG8_LDB(B1, 0, 1); PG8_STAGE(PG8_SB(0, 0), b2, voffB);
            PG8_BAR; PG8_WAIT_L(0); PG8_MMA(0, 1, At, B1); PG8_BAR;
            PG8_LDA(At, 0, 1); PG8_STAGE(PG8_SA(0, 0), a2, voffA);
            PG8_BAR; PG8_WAIT_L(0); PG8_MMA(1, 0, At, B0); PG8_BAR; PG8_SCHED;
            PG8_STAGE(PG8_SB(0, 1), b2 + hstep, voffB);
            PG8_WAIT_V(6); PG8_BAR; PG8_MMA(1, 1, At, B1); PG8_BAR;
            PG8_LDB(B0, 1, 0); PG8_SCHED; PG8_LDA(At, 1, 0); PG8_STAGE(PG8_SA(0, 1), a2 + hstep, voffA);
            PG8_WAIT_L(8); PG8_BAR; PG8_WAIT_L(0); PG8_MMA(0, 0, At, B0); PG8_BAR; PG8_SCHED;
            PG8_LDB(B1, 1, 1); PG8_STAGE(PG8_SB(1, 0), b3, voffB);
            PG8_BAR; PG8_WAIT_L(0); PG8_MMA(0, 1, At, B1); PG8_BAR;
            PG8_LDA(At, 1, 1); PG8_STAGE(PG8_SA(1, 0), a3, voffA);
            PG8_BAR; PG8_WAIT_L(0); PG8_MMA(1, 0, At, B0); PG8_BAR; PG8_SCHED;
            PG8_STAGE(PG8_SB(1, 1), b3 + hstep, voffB);
            PG8_WAIT_V(6); PG8_BAR; PG8_MMA(1, 1, At, B1); PG8_BAR;
            }
        }
        if constexpr (ALIGN_EPI) { if (wr == 0) PG8_BAR; }
        if constexpr (!Epi::AFTER_DRAIN) { E(acc, cur, wr, wc, fr, fq); S.done(cur); }
        if (!has_next) break;
#pragma unroll
        for (int a = 0; a < 2; ++a)
#pragma unroll
            for (int b = 0; b < 2; ++b)
#pragma unroll
                for (int m = 0; m < 4; ++m)
#pragma unroll
                    for (int n = 0; n < 2; ++n) acc[a][b][m][n] = (f32x4){0.f, 0.f, 0.f, 0.f};
        cur = nxt; cA = nA; cB = nB; ++ui;
        if constexpr (ALIGN_EPI) { if (wr == 1) PG8_BAR; }
    }
    PG8_WAIT_V(0);
    if constexpr (!ALIGN_EPI) { if (wr == 0) PG8_BAR; }
    PG8_BAR;
    if constexpr (Epi::AFTER_DRAIN) { E.fused(acc, cur, wr, wc, fr, fq, lds, wid, lane); S.done(cur); }
#undef PG8_SA
#undef PG8_SB
#undef PG8_STAGE
#undef PG8_LDA
#undef PG8_LDB
#undef PG8_MMA
#undef PG8_WAIT_V
#undef PG8_WAIT_L
#undef PG8_BAR
#undef PG8_SCHED
}
}

#ifndef PG8_SP2
#define PG8_SP2 true
#endif
#ifndef PG8_ALIGN
#define PG8_ALIGN true
#endif
#define DI __device__ __forceinline__
typedef unsigned short us;
typedef short bf16x8 __attribute__((ext_vector_type(8)));
typedef short s16x4 __attribute__((ext_vector_type(4)));
typedef float f32x4 __attribute__((ext_vector_type(4)));
typedef float f32x16 __attribute__((ext_vector_type(16)));
typedef unsigned u32x4 __attribute__((ext_vector_type(4)));
typedef unsigned u32x2 __attribute__((ext_vector_type(2)));
#define MFMA32(a, b, c) __builtin_amdgcn_mfma_f32_32x32x16_bf16((a), (b), (c), 0, 0, 0)

constexpr int M = 16384, DM = 1024, NL = 4, FF = 4096, DINP = 2304, DIN = 2214;
constexpr float EPS = 1e-6f;
constexpr size_t MiB = 1u << 20;
constexpr size_t WS_CTL = 0, WS_ROPE = 1 * MiB, WS_SSQ = 3 * MiB, WS_DT = 5 * MiB, WS_ACUM = 5 * MiB + 512 * 1024, WS_DEC = 6 * MiB;
constexpr size_t WS_WIN = 8 * MiB, WS_WQB = 12 * MiB + 512 * 1024, WS_WKN = 13 * MiB + 256 * 1024, WS_WV = 13 * MiB + 512 * 1024, WS_WOUT = 14 * MiB, WS_W1 = 16 * MiB, WS_W2 = 24 * MiB;
constexpr size_t WS_XN = 32 * MiB, WS_Y = 32 * MiB  , WS_MIX = 64 * MiB, WS_H = 96 * MiB;
constexpr size_t WS_U = 96 * MiB, WS_V = 104 * MiB, WS_ZS = 112 * MiB, WS_XBC = 124 * MiB, WS_CQ = 144 * MiB, WS_CKV = 156 * MiB, WS_Q = 164 * MiB, WS_K = 182 * MiB, WS_VT = 200 * MiB, WS_CC = 212 * MiB;
constexpr size_t WS_ST = 224 * MiB, WS_SSQX = 236 * MiB, WS_WOUT2 = 238 * MiB, WS_RSTD = 240 * MiB, WS_END = 241 * MiB;
constexpr int LDS_BYTES = 147456;
constexpr float QSCALE = 0.10206207261596575f * 1.4426950408889634f;

DI float bf2f(us b) { return __uint_as_float(((unsigned)b) << 16); }
typedef __bf16 bf16x2_t __attribute__((ext_vector_type(2)));
typedef float f32x2_t __attribute__((ext_vector_type(2)));
DI unsigned pk2(float lo, float hi) { f32x2_t v = {lo, hi}; bf16x2_t b = __builtin_convertvector(v, bf16x2_t); return __builtin_bit_cast(unsigned, b); }
DI us f2bf(float f) { return (us)(pk2(f, 0.f) & 0xffffu); }
DI int crow(int i, int hf) { return (i & 3) + 8 * (i >> 2) + 4 * hf; }
DI float wave_sum(float v) {
#pragma unroll
    for (int o = 1; o < 64; o <<= 1) v += __shfl_xor(v, o);
    return v;
}
DI float gelu_tanh(float x) { const float u = 0.7978845608028654f * (x + 0.044715f * x * x * x); return x * __builtin_amdgcn_rcpf(1.f + __builtin_amdgcn_exp2f(-2.885390081777927f * u)); }
DI float silu(float x) { return x * __builtin_amdgcn_rcpf(1.f + __builtin_amdgcn_exp2f(-1.4426950408889634f * x)); }
DI float softplus(float x) { return x > 20.f ? x : log1pf(__expf(x)); }
DI int rope_src(int j) { const int g = j >> 3, w = j & 7, i = g * 4 + (w & 3); return (w < 4) ? i : 16 + i; }
#define LDS_WAIT() asm volatile("s_waitcnt lgkmcnt(0)" ::: "memory")

DI void mm32(f32x16& acc, const us* A, int lda, const us* B, int ldb, int ksteps, int lane) {
    const int r = lane & 31, hf = lane >> 5;
    const us* ap = A + r * lda + 8 * hf; const us* bp = B + r * ldb + 8 * hf;
    for (int ks = 0; ks < ksteps; ++ks) { const bf16x8 a = *(const bf16x8*)(ap + 16 * ks); const bf16x8 b = *(const bf16x8*)(bp + 16 * ks); acc = MFMA32(a, b, acc); }
}

struct Params { const float* in[21]; float* out; unsigned char* ws; };

template <int MODE> DI int src_col(int r) {
    if (MODE == 0) return r;
    if (MODE == 1) { if (r < 1536) return r; if (r < 2176) return r + 6; if (r < 2208) return 2182 + rope_src(r - 2176); if (r < 2214) return 1536 + (r - 2208); return -1; }
    if (MODE == 2) { if (r >= 576) return -1; const int hd = r / 96, w = r % 96; return w < 64 ? r : hd * 96 + 64 + rope_src(w - 64); }
    if (MODE == 3) { if (r >= 384) return -1; return (r >> 6) * 128 + (r & 63); }
    if (r >= 384) return -1; return (r >> 6) * 128 + 64 + (r & 63);
}
template <int MODE> DI void tr_item(const float* __restrict__ W, int K, int Nsrc, us* WT, const float* gk, float* scr, int item, int nblk, int lane) {
    asm volatile("" : "+v"(lane));
    const int kb = item / nblk, nb = item % nblk, k0 = 64 * kb, n0 = 32 * nb;
    const int sc = src_col<MODE>(n0 + (lane & 31));
#pragma unroll 8
    for (int i = 0; i < 32; ++i) { const int kk = 2 * i + (lane >> 5); float v = sc >= 0 ? W[(size_t)(k0 + kk) * Nsrc + sc] : 0.f; if (gk) v *= gk[k0 + kk]; scr[kk * 33 + (lane & 31)] = v; }
    LDS_WAIT();
    const int c = lane & 7;
#pragma unroll
    for (int j = 0; j < 4; ++j) { const int n = (lane >> 3) + 8 * j; const float* s = scr + (8 * c) * 33 + n;
        u32x4 o; o.x = pk2(s[0 * 33], s[1 * 33]); o.y = pk2(s[2 * 33], s[3 * 33]); o.z = pk2(s[4 * 33], s[5 * 33]); o.w = pk2(s[6 * 33], s[7 * 33]);
        *(u32x4*)(WT + (size_t)(n0 + n) * K + k0 + 8 * c) = o; }
    LDS_WAIT();
}

DI void tr_item_v4(const float* __restrict__ W, int K, int N, us* WT, const float* gk, float* scr, int item, int nblk, int lane) {
    asm volatile("" : "+v"(lane));
    const int kb = item / nblk, nb = item % nblk, k0 = 64 * kb, n0 = 32 * nb, kr = lane >> 3, n4 = 4 * (lane & 7);
    f32x4 v[8];
#pragma unroll
    for (int j = 0; j < 8; ++j) v[j] = *(const f32x4*)(W + (size_t)(k0 + 8 * j + kr) * N + n0 + n4);
#pragma unroll
    for (int j = 0; j < 8; ++j) { const int kk = 8 * j + kr; const float gsc = gk ? gk[k0 + kk] : 1.f;
        scr[kk * 33 + n4] = v[j][0] * gsc; scr[kk * 33 + n4 + 1] = v[j][1] * gsc; scr[kk * 33 + n4 + 2] = v[j][2] * gsc; scr[kk * 33 + n4 + 3] = v[j][3] * gsc; }
    LDS_WAIT();
    const int c = lane & 7;
#pragma unroll
    for (int j = 0; j < 4; ++j) { const int n = (lane >> 3) + 8 * j; const float* s = scr + (8 * c) * 33 + n;
        u32x4 o; o.x = pk2(s[0 * 33], s[1 * 33]); o.y = pk2(s[2 * 33], s[3 * 33]); o.z = pk2(s[4 * 33], s[5 * 33]); o.w = pk2(s[6 * 33], s[7 * 33]);
        *(u32x4*)(WT + (size_t)(n0 + n) * K + k0 + 8 * c) = o; }
    LDS_WAIT();
}

DI void norm_rows_bf16(const float* x, const float* g, us* XN, int gw, int NGW, int lane) {
    asm volatile("" : "+v"(lane));
    f32x4 gv[4];
#pragma unroll
    for (int j = 0; j < 4; ++j) gv[j] = *(const f32x4*)(g + 4 * lane + 256 * j);
    for (int m = gw; m < M; m += NGW) {
        const f32x4* xr = (const f32x4*)(x + (size_t)m * DM) + lane;
        f32x4 v[4]; float s = 0.f;
#pragma unroll
        for (int j = 0; j < 4; ++j) { v[j] = xr[64 * j]; s += (v[j].x * v[j].x + v[j].y * v[j].y) + (v[j].z * v[j].z + v[j].w * v[j].w); }
        const float rstd = rsqrtf(wave_sum(s) * (1.f / DM) + EPS);
        u32x2* o = (u32x2*)(XN + (size_t)m * DM) + lane;
#pragma unroll
        for (int j = 0; j < 4; ++j) { u32x2 w; w.x = pk2(v[j].x * rstd * gv[j].x, v[j].y * rstd * gv[j].y); w.y = pk2(v[j].z * rstd * gv[j].z, v[j].w * rstd * gv[j].w); o[64 * j] = w; }
    }
}
DI void x_to_bf16_ssq(const float* x, us* XB, float* SSQX, int gw, int NGW, int lane) {
    asm volatile("" : "+v"(lane));
    for (int m = gw; m < M; m += NGW) {
        const f32x4* xr = (const f32x4*)(x + (size_t)m * DM) + lane;
        f32x4 v[4]; float s = 0.f;
#pragma unroll
        for (int j = 0; j < 4; ++j) { v[j] = xr[64 * j]; s += (v[j].x * v[j].x + v[j].y * v[j].y) + (v[j].z * v[j].z + v[j].w * v[j].w); }
        s = wave_sum(s);
        u32x2* o = (u32x2*)(XB + (size_t)m * DM) + lane;
#pragma unroll
        for (int j = 0; j < 4; ++j) { u32x2 w; w.x = pk2(v[j].x, v[j].y); w.y = pk2(v[j].z, v[j].w); o[64 * j] = w; }
        if (lane < 32) SSQX[m * 32 + lane] = lane == 0 ? s : 0.f;
    }
}
DI void norm_rows_out(const us* xb, float* out, const float* g, int gw, int NGW, int lane) {
    asm volatile("" : "+v"(lane));
    f32x4 gv[4];
#pragma unroll
    for (int j = 0; j < 4; ++j) gv[j] = *(const f32x4*)(g + 4 * lane + 256 * j);
    for (int m = gw; m < M; m += NGW) {
        const u32x2* xr = (const u32x2*)(xb + (size_t)m * DM) + lane;
        f32x4 v[4]; float s = 0.f;
#pragma unroll
        for (int j = 0; j < 4; ++j) { const u32x2 w = xr[64 * j]; v[j] = (f32x4){__uint_as_float(w.x << 16), __uint_as_float(w.x & 0xffff0000u), __uint_as_float(w.y << 16), __uint_as_float(w.y & 0xffff0000u)};
            s += (v[j].x * v[j].x + v[j].y * v[j].y) + (v[j].z * v[j].z + v[j].w * v[j].w); }
        const float rstd = rsqrtf(wave_sum(s) * (1.f / DM) + EPS);
        f32x4* o = (f32x4*)(out + (size_t)m * DM) + lane;
#pragma unroll
        for (int j = 0; j < 4; ++j) o[64 * j] = v[j] * rstd * gv[j];
    }
}

using pg8::Unit;
DI void st_bf16x8(us* p, f32x4 a, f32x4 b) { u32x4 w; w.x = pk2(a[0], a[1]); w.y = pk2(a[2], a[3]); w.z = pk2(b[0], b[1]); w.w = pk2(b[2], b[3]); *(u32x4*)p = w; }
DI float sq8(f32x4 a, f32x4 b) { return (a[0] * a[0] + a[1] * a[1]) + (a[2] * a[2] + a[3] * a[3]) + (b[0] * b[0] + b[1] * b[1]) + (b[2] * b[2] + b[3] * b[3]); }

DI float rstd_x(const float* SSQX, int row) {
    const f32x4* p = (const f32x4*)(SSQX + (size_t)row * 32); f32x4 s = p[0];
#pragma unroll
    for (int j = 1; j < 8; ++j) s += p[j];
    return rsqrtf(((s[0] + s[1]) + (s[2] + s[3])) * (1.f / DM) + EPS);
}
DI void prep_rstd(const pg8::StaticOrder& S, const float* SSQX, float* RSTD) {
    int tid = threadIdx.x; asm volatile("" : "+v"(tid));
    Unit u;
    for (int i = 0; S.next(i, u); ++i) {
        const int row = u.pm * 256 + (tid >> 1);
        const f32x4* p = (const f32x4*)(SSQX + (size_t)row * 32 + (tid & 1) * 16);
        const f32x4 s = (p[0] + p[1]) + (p[2] + p[3]);
        float t = (s[0] + s[1]) + (s[2] + s[3]); t += __shfl_xor(t, 1);
        if ((tid & 1) == 0) RSTD[row] = rsqrtf(t * (1.f / DM) + EPS);
    }
    asm volatile("s_waitcnt vmcnt(0)" ::: "memory");
    __syncthreads();
}
struct EpiIn {
    static constexpr bool PERM = true, AFTER_DRAIN = false;
    unsigned char* ws;
    DI void operator()(const f32x4 (&acc)[2][2][4][2], const Unit& u, int wr, int wc, int fr, int fq) const {
        asm volatile("" : "+v"(fr), "+v"(fq));
        us* U = (us*)(ws + WS_U); us* V = (us*)(ws + WS_V); us* ZS = (us*)(ws + WS_ZS); us* XBC = (us*)(ws + WS_XBC); us* CQ = (us*)(ws + WS_CQ); us* CKV = (us*)(ws + WS_CKV); us* K = (us*)(ws + WS_K);
        float* SSQ = (float*)(ws + WS_SSQ); float* DT = (float*)(ws + WS_DT); const float* rope = (const float*)(ws + WS_ROPE);
        float rxa[2][4];
#pragma unroll
        for (int ai = 0; ai < 2; ++ai)
#pragma unroll
            for (int m = 0; m < 4; ++m) rxa[ai][m] = ((const float*)(ws + WS_RSTD))[u.pm * 256 + ai * 128 + wr * 64 + m * 16 + fr];
#pragma unroll
        for (int bj = 0; bj < 2; ++bj) {
            const int sg = 2 * u.pn + bj, c0 = 32 * wc + 8 * fq;
#pragma unroll
            for (int ai = 0; ai < 2; ++ai)
#pragma unroll
                for (int m = 0; m < 4; ++m) {
                    const int row = u.pm * 256 + ai * 128 + wr * 64 + m * 16 + fr;
                    const float rx = rxa[ai][m];
                    f32x4 v0 = acc[ai][bj][m][0] * rx, v1 = acc[ai][bj][m][1] * rx;
                    if (sg < 4) {
#pragma unroll
                        for (int e = 0; e < 4; ++e) { v0[e] = gelu_tanh(v0[e]); v1[e] = gelu_tanh(v1[e]); }
                        st_bf16x8((sg < 2 ? U : V) + (size_t)row * 256 + (sg & 1) * 128 + c0, v0, v1);
                        if (sg >= 2) { float s = sq8(v0, v1); s += __shfl_xor(s, 16); s += __shfl_xor(s, 32); if (fq == 0) SSQ[row * 32 + (sg - 2) * 4 + wc] = s; }
                    } else if (sg < 7) {
#pragma unroll
                        for (int e = 0; e < 4; ++e) { v0[e] = silu(v0[e]); v1[e] = silu(v1[e]); }
                        st_bf16x8(ZS + (size_t)row * 384 + (sg - 4) * 128 + c0, v0, v1);
                    } else if (sg < 12) {
                        st_bf16x8(XBC + (size_t)row * 640 + (sg - 7) * 128 + c0, v0, v1);
                    } else if (sg < 15) {
                        st_bf16x8(CQ + (size_t)row * 384 + (sg - 12) * 128 + c0, v0, v1);
                        float s = sq8(v0, v1); s += __shfl_xor(s, 16); s += __shfl_xor(s, 32); if (fq == 0) SSQ[row * 32 + 8 + (sg - 12) * 4 + wc] = s;
                    } else if (sg < 17) {
                        st_bf16x8(CKV + (size_t)row * 256 + (sg - 15) * 128 + c0, v0, v1);
                        float s = sq8(v0, v1); s += __shfl_xor(s, 16); s += __shfl_xor(s, 32); if (fq == 0) SSQ[row * 32 + 20 + (sg - 15) * 4 + wc] = s;
                    } else {
                        if (wc == 0) {
                            const f32x4 cs0 = *(const f32x4*)(rope + (size_t)row * 32 + 8 * fq), cs1 = *(const f32x4*)(rope + (size_t)row * 32 + 8 * fq + 4);
                            const float c[4] = {cs0[0], cs0[2], cs1[0], cs1[2]}, s[4] = {cs0[1], cs0[3], cs1[1], cs1[3]};
                            f32x4 o1, o2;
#pragma unroll
                            for (int e = 0; e < 4; ++e) { o1[e] = v0[e] * c[e] - v1[e] * s[e]; o2[e] = v1[e] * c[e] + v0[e] * s[e]; }
#pragma unroll
                            for (int hd = 0; hd < 6; ++hd) st_bf16x8(K + ((size_t)hd * M + row) * 96 + 64 + 8 * fq, o1, o2);
                        } else if (wc == 1 && fq == 0) { *(f32x4*)(DT + row * 8) = v0; *(f32x4*)(DT + row * 8 + 4) = v1; }
                    }
                }
        }
    }
};
struct EpiQ {
    static constexpr bool PERM = true, AFTER_DRAIN = false;
    us* Q; const float* SSQ; const float* rope;
    DI void operator()(const f32x4 (&acc)[2][2][4][2], const Unit& u, int wr, int wc, int fr, int fq) const {
        asm volatile("" : "+v"(fr), "+v"(fq));
#pragma unroll
        for (int ai = 0; ai < 2; ++ai)
#pragma unroll
            for (int m = 0; m < 4; ++m) {
                const int row = u.pm * 256 + ai * 128 + wr * 64 + m * 16 + fr;
                const f32x4 a = *(const f32x4*)(SSQ + row * 32 + 8), b = *(const f32x4*)(SSQ + row * 32 + 12), c = *(const f32x4*)(SSQ + row * 32 + 16);
                const float ss = ((a[0] + a[1]) + (a[2] + a[3])) + ((b[0] + b[1]) + (b[2] + b[3])) + ((c[0] + c[1]) + (c[2] + c[3]));
                const float sc = rsqrtf(ss * (1.f / 384.f) + EPS) * QSCALE;
#pragma unroll
                for (int bj = 0; bj < 2; ++bj) {
                    const int colb = u.pn * 256 + bj * 128 + 32 * wc;
                    if (colb >= 576) continue;
                    f32x4 v0 = acc[ai][bj][m][0] * sc, v1 = acc[ai][bj][m][1] * sc;
                    if ((colb >> 5) % 3 == 2) {
                        const f32x4 cs0 = *(const f32x4*)(rope + (size_t)row * 32 + 8 * fq), cs1 = *(const f32x4*)(rope + (size_t)row * 32 + 8 * fq + 4);
                        const float cc[4] = {cs0[0], cs0[2], cs1[0], cs1[2]}, sn[4] = {cs0[1], cs0[3], cs1[1], cs1[3]};
                        f32x4 o1, o2;
#pragma unroll
                        for (int e = 0; e < 4; ++e) { o1[e] = v0[e] * cc[e] - v1[e] * sn[e]; o2[e] = v1[e] * cc[e] + v0[e] * sn[e]; }
                        v0 = o1; v1 = o2;
                    }
                    st_bf16x8(Q + ((size_t)(colb / 96) * M + row) * 96 + (colb % 96) + 8 * fq, v0, v1);
                }
            }
    }
};
struct EpiKn {
    static constexpr bool PERM = true, AFTER_DRAIN = false;
    us* K; const float* SSQ;
    DI void operator()(const f32x4 (&acc)[2][2][4][2], const Unit& u, int wr, int wc, int fr, int fq) const {
        asm volatile("" : "+v"(fr), "+v"(fq));
#pragma unroll
        for (int ai = 0; ai < 2; ++ai)
#pragma unroll
            for (int m = 0; m < 4; ++m) {
                const int row = u.pm * 256 + ai * 128 + wr * 64 + m * 16 + fr;
                const f32x4 a = *(const f32x4*)(SSQ + row * 32 + 20), b = *(const f32x4*)(SSQ + row * 32 + 24);
                const float sc = rsqrtf((((a[0] + a[1]) + (a[2] + a[3])) + ((b[0] + b[1]) + (b[2] + b[3]))) * (1.f / 256.f) + EPS);
#pragma unroll
                for (int bj = 0; bj < 2; ++bj) {
                    const int col = u.pn * 256 + bj * 128 + 32 * wc + 8 * fq;
                    if (col >= 384) continue;
                    st_bf16x8(K + ((size_t)(col >> 6) * M + row) * 96 + (col & 63), acc[ai][bj][m][0] * sc, acc[ai][bj][m][1] * sc);
                }
            }
    }
};
struct EpiVt {
    static constexpr bool PERM = true, AFTER_DRAIN = false;
    us* VT; const float* SSQ;
    DI void operator()(const f32x4 (&acc)[2][2][4][2], const Unit& u, int wr, int wc, int fr, int fq) const {
        asm volatile("" : "+v"(fr), "+v"(fq));
#pragma unroll
        for (int bj = 0; bj < 2; ++bj) {
            const int tok0 = u.pn * 256 + bj * 128 + 32 * wc + 8 * fq;
            float rs[8];
#pragma unroll
            for (int e = 0; e < 8; ++e) { const f32x4 a = *(const f32x4*)(SSQ + (tok0 + e) * 32 + 20), b = *(const f32x4*)(SSQ + (tok0 + e) * 32 + 24);
                rs[e] = rsqrtf((((a[0] + a[1]) + (a[2] + a[3])) + ((b[0] + b[1]) + (b[2] + b[3]))) * (1.f / 256.f) + EPS); }
#pragma unroll
            for (int ai = 0; ai < 2; ++ai)
#pragma unroll
                for (int m = 0; m < 4; ++m) {
                    const int f = u.pm * 256 + ai * 128 + wr * 64 + m * 16 + fr;
                    if (f >= 384) continue;
                    f32x4 v0 = acc[ai][bj][m][0], v1 = acc[ai][bj][m][1];
#pragma unroll
                    for (int e = 0; e < 4; ++e) { v0[e] *= rs[e]; v1[e] *= rs[4 + e]; }
                    st_bf16x8(VT + (size_t)f * M + tok0, v0, v1);
                }
        }
    }
};
struct EpiRes {
    static constexpr bool PERM = true, AFTER_DRAIN = false;
    us* XB; float* SSQX;
    DI void operator()(const f32x4 (&acc)[2][2][4][2], const Unit& u, int wr, int wc, int fr, int fq) const {
        asm volatile("" : "+v"(fr), "+v"(fq));
#pragma unroll
        for (int ai = 0; ai < 2; ++ai)
#pragma unroll
            for (int m = 0; m < 4; ++m) {
                const int row = u.pm * 256 + ai * 128 + wr * 64 + m * 16 + fr;
#pragma unroll
                for (int bj = 0; bj < 2; ++bj) {
                    const size_t o = (size_t)row * DM + u.pn * 256 + bj * 128 + 32 * wc + 8 * fq;
                    const u32x4 xv = *(const u32x4*)(XB + o);
                    const f32x4 x0 = (f32x4){__uint_as_float(xv.x << 16), __uint_as_float(xv.x & 0xffff0000u), __uint_as_float(xv.y << 16), __uint_as_float(xv.y & 0xffff0000u)} + acc[ai][bj][m][0];
                    const f32x4 x1 = (f32x4){__uint_as_float(xv.z << 16), __uint_as_float(xv.z & 0xffff0000u), __uint_as_float(xv.w << 16), __uint_as_float(xv.w & 0xffff0000u)} + acc[ai][bj][m][1];
                    st_bf16x8(XB + o, x0, x1);
                    float s = sq8(x0, x1); s += __shfl_xor(s, 16); s += __shfl_xor(s, 32);
                    if (fq == 0) SSQX[row * 32 + u.pn * 8 + bj * 4 + wc] = s;
                }
            }
    }
};
struct EpiRelu2 {
    static constexpr bool PERM = true, AFTER_DRAIN = false;
    us* H; const float* RSTD;
    DI void operator()(const f32x4 (&acc)[2][2][4][2], const Unit& u, int wr, int wc, int fr, int fq) const {
        asm volatile("" : "+v"(fr), "+v"(fq));
        float rxa[2][4];
#pragma unroll
        for (int ai = 0; ai < 2; ++ai)
#pragma unroll
            for (int m = 0; m < 4; ++m) rxa[ai][m] = RSTD[u.pm * 256 + ai * 128 + wr * 64 + m * 16 + fr];
#pragma unroll
        for (int ai = 0; ai < 2; ++ai)
#pragma unroll
            for (int m = 0; m < 4; ++m) {
                const int row = u.pm * 256 + ai * 128 + wr * 64 + m * 16 + fr;
                const float rx = rxa[ai][m];
#pragma unroll
                for (int bj = 0; bj < 2; ++bj) {
                    f32x4 v0 = acc[ai][bj][m][0], v1 = acc[ai][bj][m][1];
#pragma unroll
                    for (int e = 0; e < 4; ++e) { const float a = fmaxf(v0[e], 0.f) * rx, b = fmaxf(v1[e], 0.f) * rx; v0[e] = a * a; v1[e] = b * b; }
                    st_bf16x8(H + (size_t)row * FF + u.pn * 256 + bj * 128 + 32 * wc + 8 * fq, v0, v1);
                }
            }
    }
};
DI void ld16bf(const us* p, float* o) {
    const u32x4 a = *(const u32x4*)p, b = *(const u32x4*)(p + 8);
    const unsigned w[8] = {a.x, a.y, a.z, a.w, b.x, b.y, b.z, b.w};
#pragma unroll
    for (int j = 0; j < 8; ++j) { o[2 * j] = __uint_as_float(w[j] << 16); o[2 * j + 1] = __uint_as_float(w[j] & 0xffff0000u); }
}
DI void conv16(const us* XBC, int row, int col, const float* cw, const float* cb, float* o) {
#pragma unroll
    for (int j = 0; j < 16; ++j) o[j] = cb[col + j];
#pragma unroll
    for (int k = 0; k < 4; ++k) {
        const int r = row - 3 + k;
        if (r >= 0) { float x[16]; ld16bf(XBC + (size_t)r * 640 + col, x);
#pragma unroll
            for (int j = 0; j < 16; ++j) o[j] += cw[k * 640 + col + j] * x[j]; }
    }
#pragma unroll
    for (int j = 0; j < 16; ++j) o[j] = silu(o[j]);
}
DI void st16bf(us* p, const float* o) {
    u32x4 a, b; a.x = pk2(o[0], o[1]); a.y = pk2(o[2], o[3]); a.z = pk2(o[4], o[5]); a.w = pk2(o[6], o[7]); b.x = pk2(o[8], o[9]); b.y = pk2(o[10], o[11]); b.z = pk2(o[12], o[13]); b.w = pk2(o[14], o[15]);
    *(u32x4*)p = a; *(u32x4*)(p + 8) = b;
}

struct ConvIn { u32x2 v[7]; f32x4 w[4]; f32x4 b; };
DI void conv4x4_load(ConvIn& ci, const us* XBC, int row0, int col, const float* cw, const float* cb) {
#pragma unroll
    for (int r7 = 0; r7 < 7; ++r7) { const int rr = row0 - 3 + r7; ci.v[r7] = (u32x2){0u, 0u}; if (rr >= 0) ci.v[r7] = *(const u32x2*)(XBC + (size_t)rr * 640 + col); }
#pragma unroll
    for (int k = 0; k < 4; ++k) ci.w[k] = *(const f32x4*)(cw + k * 640 + col);
    ci.b = *(const f32x4*)(cb + col);
}
DI void conv4x4_compute(const ConvIn& ci, float (&o)[4][4]) {
    float x[7][4];
#pragma unroll
    for (int r7 = 0; r7 < 7; ++r7) { const u32x2 v = ci.v[r7];
        x[r7][0] = __uint_as_float(v.x << 16); x[r7][1] = __uint_as_float(v.x & 0xffff0000u); x[r7][2] = __uint_as_float(v.y << 16); x[r7][3] = __uint_as_float(v.y & 0xffff0000u); }
#pragma unroll
    for (int tt = 0; tt < 4; ++tt)
#pragma unroll
        for (int j = 0; j < 4; ++j) o[tt][j] = silu(ci.b[j] + (ci.w[0][j] * x[tt][j] + ci.w[1][j] * x[tt + 1][j]) + (ci.w[2][j] * x[tt + 2][j] + ci.w[3][j] * x[tt + 3][j]));
}
DI void conv4x4(const us* XBC, int row0, int col, const float* cw, const float* cb, float (&o)[4][4]) { ConvIn ci; conv4x4_load(ci, XBC, row0, col, cw, cb); conv4x4_compute(ci, o); }
DI u32x2 pk4(float a, float b, float c, float d) { u32x2 r; r.x = pk2(a, b); r.y = pk2(c, d); return r; }
DI void ssd_item(unsigned char* smem, int c, int g, const us* XBC, const float* DT, const float* cw, const float* cb, const float* dt_bias, const float* a_log, const float* d_skip,
                 us* Y, float* ST, float* ACUM, float* DEC, us* CC) {
    us* Cs = (us*)smem; us* Bs = (us*)(smem + 18432); us* BT = (us*)(smem + 36864); us* XT = (us*)(smem + 54272); us* XS = (us*)(smem + 71680); us* Wm = (us*)(smem + 89088);
    float* av = (float*)(smem + 123904); float* dtv = (float*)(smem + 125440);
    int tid_l = threadIdx.x; asm volatile("" : "+v"(tid_l));
    const int tid = tid_l, wave = tid >> 6, lane = tid & 63, hf = lane >> 5;
    const int t0 = (tid >> 4) * 4, cc = (tid & 15) * 4, row0 = c * 128 + t0;
    if (wave < 3) {
        const int h = 3 * g + wave; const float A = -__expf(a_log[h]), bias = dt_bias[h];
        const int s0 = 2 * lane, s1 = s0 + 1;
        const float dt0 = softplus(DT[(c * 128 + s0) * 8 + h] + bias), dt1 = softplus(DT[(c * 128 + s1) * 8 + h] + bias);
        const float x0 = dt0 * A, x1 = x0 + dt1 * A;
        float incl = x1;
#pragma unroll
        for (int o = 1; o < 64; o <<= 1) { const float y = __shfl_up(incl, o); if (lane >= o) incl += y; }
        const float excl = incl - x1;
        av[wave * 128 + s0] = excl + x0; av[wave * 128 + s1] = excl + x1; dtv[wave * 128 + s0] = dt0; dtv[wave * 128 + s1] = dt1;
        ACUM[(c * 128 + s0) * 8 + h] = excl + x0; ACUM[(c * 128 + s1) * 8 + h] = excl + x1;
        if (lane == 63) DEC[c * 8 + h] = __expf(incl);
    }
    {
        float o[4][4];
        conv4x4(XBC, row0, 384 + 64 * g + cc, cw, cb, o);
#pragma unroll
        for (int tt = 0; tt < 4; ++tt) *(u32x2*)(Bs + (t0 + tt) * 72 + cc) = pk4(o[tt][0], o[tt][1], o[tt][2], o[tt][3]);
#pragma unroll
        for (int j = 0; j < 4; ++j) *(u32x2*)(BT + (cc + j) * 136 + t0) = pk4(o[0][j], o[1][j], o[2][j], o[3][j]);
        conv4x4(XBC, row0, 512 + 64 * g + cc, cw, cb, o);
#pragma unroll
        for (int tt = 0; tt < 4; ++tt) { const u32x2 v = pk4(o[tt][0], o[tt][1], o[tt][2], o[tt][3]); *(u32x2*)(Cs + (t0 + tt) * 72 + cc) = v; *(u32x2*)(CC + (size_t)(row0 + tt) * 128 + 64 * g + cc) = v; }
    }
    __syncthreads();
    const int tb = wave >> 1, sb0 = 2 * (wave & 1);
    f32x16 cbm[2];
#pragma unroll
    for (int i = 0; i < 16; ++i) { cbm[0][i] = 0.f; cbm[1][i] = 0.f; }
    mm32(cbm[0], Cs + tb * 32 * 72, 72, Bs + sb0 * 32 * 72, 72, 4, lane);
    mm32(cbm[1], Cs + tb * 32 * 72, 72, Bs + (sb0 + 1) * 32 * 72, 72, 4, lane);
#pragma unroll 1
    for (int hh = 0; hh < 3; ++hh) {
        const int h = 3 * g + hh;
        {
            float o[4][4];
            conv4x4(XBC, row0, 64 * h + cc, cw, cb, o);
            float dte[4];
#pragma unroll
            for (int tt = 0; tt < 4; ++tt) dte[tt] = __expf(av[hh * 128 + 127] - av[hh * 128 + t0 + tt]) * dtv[hh * 128 + t0 + tt];
#pragma unroll
            for (int j = 0; j < 4; ++j) { *(u32x2*)(XT + (cc + j) * 136 + t0) = pk4(o[0][j], o[1][j], o[2][j], o[3][j]);
                *(u32x2*)(XS + (cc + j) * 136 + t0) = pk4(o[0][j] * dte[0], o[1][j] * dte[1], o[2][j] * dte[2], o[3][j] * dte[3]); }
        }
#pragma unroll
        for (int blk = 0; blk < 2; ++blk) {
            const int s = (sb0 + blk) * 32 + (lane & 31); const float as = av[hh * 128 + s], dts = dtv[hh * 128 + s];
#pragma unroll
            for (int i = 0; i < 16; ++i) { const int t_ = tb * 32 + crow(i, hf);
                float w = cbm[blk][i] * __builtin_amdgcn_exp2f(fminf(av[hh * 128 + t_] - as, 0.f) * 1.4426950408889634f) * dts;
                w = (s <= t_) ? w : 0.f;
                Wm[t_ * 136 + s] = f2bf(w); }
        }
        __syncthreads();
        {
            const int pb = wave & 1; f32x16 acc;
#pragma unroll
            for (int i = 0; i < 16; ++i) acc[i] = 0.f;
            mm32(acc, Wm + tb * 32 * 136, 136, XT + pb * 32 * 136, 136, 8, lane);
            const int p = pb * 32 + (lane & 31); const float dsk = d_skip[h];
#pragma unroll
            for (int i = 0; i < 16; ++i) { const int t_ = tb * 32 + crow(i, hf); Y[(size_t)(c * 128 + t_) * 384 + h * 64 + p] = f2bf(acc[i] + bf2f(XT[p * 136 + t_]) * dsk); }
        }
        if (wave < 4) {
            const int pb = wave >> 1, nb = wave & 1; f32x16 acc;
#pragma unroll
            for (int i = 0; i < 16; ++i) acc[i] = 0.f;
            mm32(acc, XS + pb * 32 * 136, 136, BT + nb * 32 * 136, 136, 8, lane);
            const int n = nb * 32 + (lane & 31);
#pragma unroll
            for (int i = 0; i < 16; ++i) { const int p_ = pb * 32 + crow(i, hf); ST[((size_t)(c * 6 + h) * 64 + p_) * 64 + n] = acc[i]; }
        }
        __syncthreads();
    }
}

DI void gmlp_item(unsigned char* smem, int c, int h, const us* U, const us* V, const float* SSQ, const float* gv, const float* w_s, const float* b_s, us* mix) {
    us* Ws = (us*)smem; us* VTs = (us*)(smem + 34816);
    int tid_l = threadIdx.x; asm volatile("" : "+v"(tid_l));
    const int tid = tid_l, wave = tid >> 6, lane = tid & 63, hf = lane >> 5;
    const int t = tid >> 2, cq = (tid & 3) * 16, row = c * 128 + t;
    {
        const f32x4 a = *(const f32x4*)(SSQ + row * 32), b = *(const f32x4*)(SSQ + row * 32 + 4);
        const float rstd = rsqrtf((((a[0] + a[1]) + (a[2] + a[3])) + ((b[0] + b[1]) + (b[2] + b[3]))) * (1.f / 256.f) + EPS);
        float x[16]; ld16bf(V + (size_t)row * 256 + 64 * h + cq, x);
#pragma unroll
        for (int j = 0; j < 16; ++j) VTs[(cq + j) * 136 + t] = f2bf(x[j] * rstd * gv[64 * h + cq + j]);
        const int s0 = (tid & 3) * 32; const float* wr = w_s + ((size_t)h * 128 + t) * 128 + s0;
#pragma unroll
        for (int q = 0; q < 4; ++q) {
            const f32x4 w0 = *(const f32x4*)(wr + 8 * q), w1 = *(const f32x4*)(wr + 8 * q + 4); f32x4 m0, m1;
#pragma unroll
            for (int e = 0; e < 4; ++e) { m0[e] = (s0 + 8 * q + e <= t) ? w0[e] : 0.f; m1[e] = (s0 + 8 * q + 4 + e <= t) ? w1[e] : 0.f; }
            st_bf16x8(Ws + t * 136 + s0 + 8 * q, m0, m1);
        }
    }
    const int tb = wave >> 1, db = wave & 1, d = db * 32 + (lane & 31);
    float uv[16], bv[16];
#pragma unroll
    for (int i = 0; i < 16; ++i) { const int t_ = tb * 32 + crow(i, hf); uv[i] = bf2f(U[((size_t)c * 128 + t_) * 256 + 64 * h + d]); bv[i] = b_s[h * 128 + t_]; }
    __syncthreads();
    {
        f32x16 acc;
#pragma unroll
        for (int i = 0; i < 16; ++i) acc[i] = 0.f;
        mm32(acc, Ws + tb * 32 * 136, 136, VTs + db * 32 * 136, 136, 8, lane);
#pragma unroll
        for (int i = 0; i < 16; ++i) { const int t_ = tb * 32 + crow(i, hf); const size_t r_ = (size_t)c * 128 + t_;
            mix[r_ * DM + 64 * h + d] = f2bf((acc[i] + bv[i]) * uv[i]); }
    }
    __syncthreads();
}

DI void ssd_final_item(unsigned char* smem, int c, int g, const us* CC, const float* ST, const us* Y, const float* ACUM, const us* ZS, const float* ng, us* mix) {
    us* Cs = (us*)smem; us* HP = (us*)(smem + 18432); float* YG = (float*)(smem + 27648);
    int tid_l = threadIdx.x; asm volatile("" : "+v"(tid_l));
    const int tid = tid_l, wave = tid >> 6, lane = tid & 63, hf = lane >> 5;
    const int t = tid >> 2, cq = (tid & 3) * 16;
    const int hp_p = tid >> 3, hp_n0 = (tid & 7) * 8;
    const int tb = wave >> 1, pb = wave & 1, p = pb * 32 + (lane & 31);
    f32x4 h0, h1;
    { const float* src = ST + ((size_t)(c * 6 + 3 * g) * 64 + hp_p) * 64 + hp_n0; h0 = *(const f32x4*)src; h1 = *(const f32x4*)(src + 4); }
    { const us* src = CC + (size_t)(c * 128 + t) * 128 + 64 * g + cq; *(u32x4*)(Cs + t * 72 + cq) = *(const u32x4*)src; *(u32x4*)(Cs + t * 72 + cq + 8) = *(const u32x4*)(src + 8); }
#pragma unroll 1
    for (int hh = 0; hh < 3; ++hh) {
        const int h = 3 * g + hh;
        st_bf16x8(HP + hp_p * 72 + hp_n0, h0, h1);
        if (hh < 2) { const float* src = ST + ((size_t)(c * 6 + h + 1) * 64 + hp_p) * 64 + hp_n0; h0 = *(const f32x4*)src; h1 = *(const f32x4*)(src + 4); }
        float yv[16], av[16], zv[16];
#pragma unroll
        for (int i = 0; i < 16; ++i) { const size_t r_ = (size_t)c * 128 + tb * 32 + crow(i, hf);
            yv[i] = bf2f(Y[r_ * 384 + h * 64 + p]); av[i] = ACUM[r_ * 8 + h]; zv[i] = bf2f(ZS[r_ * 384 + h * 64 + p]); }
        __syncthreads();
        {
            f32x16 acc;
#pragma unroll
            for (int i = 0; i < 16; ++i) acc[i] = 0.f;
            mm32(acc, Cs + tb * 32 * 72, 72, HP + pb * 32 * 72, 72, 4, lane);
#pragma unroll
            for (int i = 0; i < 16; ++i) { const int t_ = tb * 32 + crow(i, hf);
                YG[t_ * 196 + hh * 64 + p] = (yv[i] + __expf(av[i]) * acc[i]) * zv[i]; }
        }
        __syncthreads();
    }
    {
        const int part = tid & 3; const float* yr = YG + t * 196 + part * 48; float v[48]; float ss = 0.f;
#pragma unroll
        for (int q = 0; q < 12; ++q) { const f32x4 a = *(const f32x4*)(yr + 4 * q); v[4 * q] = a[0]; v[4 * q + 1] = a[1]; v[4 * q + 2] = a[2]; v[4 * q + 3] = a[3]; ss += (a[0] * a[0] + a[1] * a[1]) + (a[2] * a[2] + a[3] * a[3]); }
        ss += __shfl_xor(ss, 1); ss += __shfl_xor(ss, 2);
        const float rstd = rsqrtf(ss * (1.f / 192.f) + EPS);
        const float* gp = ng + 192 * g + part * 48; us* dst = mix + (size_t)(c * 128 + t) * DM + 256 + 192 * g + part * 48;
#pragma unroll
        for (int q = 0; q < 6; ++q) { f32x4 a, b;
#pragma unroll
            for (int e = 0; e < 4; ++e) { a[e] = v[8 * q + e] * rstd * gp[8 * q + e]; b[e] = v[8 * q + 4 + e] * rstd * gp[8 * q + 4 + e]; }
            st_bf16x8(dst + 8 * q, a, b); }
    }
    __syncthreads();
}

constexpr int ATT_NQB = 64, ATT_ITEMS = 960;
DI int att_slot(int h, int qb, int kc) { const int g = qb >> 4, b = qb & 15; const int base = (g == 1) ? 2 * b : (g == 2) ? 32 + 3 * b : 80 + 4 * b; return h * 144 + base + kc; }
DI size_t att_slot_off(int slot) { return (size_t)slot * 16384; }
DI void att_decode(int u, int& h, int& qb, int& kc) {
    if (u < 576) { h = u % 6; const int v = u / 6;
        if (v < 16) { qb = 16 + v; kc = 0; } else if (v < 48) { const int w = v - 16; qb = 32 + (w >> 1); kc = w & 1; } else { const int w = v - 48; qb = 48 + w / 3; kc = w % 3; }
    } else { const int d = u - 576; h = d % 6; const int e = d / 6, q = e & 3; qb = 16 * q + 15 - (e >> 2); kc = q; }
}
constexpr int AT_KB = 64 * 208, AT_VB = 64 * 144;
DI void attn_unit(unsigned char* smem, const us* Q, const us* K, const us* VT, us* mix, us* PO, float* PML, int h, int qb, int kc) {
    int tid_l = threadIdx.x; asm volatile("" : "+v"(tid_l));
    const int tid = tid_l, wave = tid >> 6, lane = tid & 63, r = lane & 31, hf = lane >> 5;
    const int q0 = qb * 256 + wave * 32, qrow = q0 + r;
    bf16x8 qf[6];
#pragma unroll
    for (int ks = 0; ks < 6; ++ks) qf[ks] = *(const bf16x8*)(Q + ((size_t)h * M + qrow) * 96 + 16 * ks + 8 * hf);
    f32x16 o0, o1;
#pragma unroll
    for (int i = 0; i < 16; ++i) { o0[i] = 0.f; o1[i] = 0.f; }
    float mrun = -1e30f, lrun = 0.f;
    const int t0 = 64 * kc, tend = (64 * (kc + 1) < 4 * (qb + 1)) ? 64 * (kc + 1) : 4 * (qb + 1), ntiles = tend - t0, tg = __builtin_amdgcn_readfirstlane(q0 >> 6);
    const bool masked = tg < tend; const int tlw = (masked ? tg : tend - 1) - t0;
    const int id1 = 512 + (tid & 255);
    const int kg0 = tid * 8, kl0 = (tid / 12) * 104 + (tid % 12) * 8, kg1 = id1 * 8, kl1 = (id1 / 12) * 104 + (id1 % 12) * 8;
    const int vl0 = (tid >> 3) * 72 + ((tid & 7) >> 1) * 16 + (tid & 1) * 4;
    const us* Kg = K + (size_t)h * M * 96; const us* Vg = VT + (size_t)(h * 64 + (tid >> 3)) * M + (tid & 7) * 8;
    us* Kb0 = (us*)smem; us* Kb1 = (us*)(smem + AT_KB); us* Vb0 = (us*)(smem + 2 * AT_KB); us* Vb1 = (us*)(smem + 2 * AT_KB + AT_VB);
    u32x4 ka0, ka1, va, kb0, kb1, vb;
#define AT_LDK(R0, R1, t) do { const size_t kn_ = (size_t)(t0 + ((t) < ntiles ? (t) : ntiles - 1)) * 64; R0 = *(const u32x4*)(Kg + kn_ * 96 + kg0); R1 = *(const u32x4*)(Kg + kn_ * 96 + kg1); } while (0)
#define AT_LDV(R, t) do { const size_t kn_ = (size_t)(t0 + ((t) < ntiles ? (t) : ntiles - 1)) * 64; R = *(const u32x4*)(Vg + kn_); } while (0)
#define AT_STK(R0, R1, Kb) do { *(u32x4*)((Kb) + kl0) = R0; *(u32x4*)((Kb) + kl1) = R1; } while (0)
#define AT_STV(R, Vb) do { *(u32x2*)((Vb) + vl0) = (u32x2){R.x, R.y}; *(u32x2*)((Vb) + vl0 + 8) = (u32x2){R.z, R.w}; } while (0)
#define AT_QK(S0, S1, Kb) do { \
        _Pragma("unroll") for (int i = 0; i < 16; ++i) { S0[i] = 0.f; S1[i] = 0.f; } \
        _Pragma("unroll") for (int ks = 0; ks < 6; ++ks) { \
            const bf16x8 a0 = *(const bf16x8*)((Kb) + r * 104 + 16 * ks + 8 * hf), a1 = *(const bf16x8*)((Kb) + (32 + r) * 104 + 16 * ks + 8 * hf); \
            S0 = MFMA32(a0, qf[ks], S0); S1 = MFMA32(a1, qf[ks], S1); } } while (0)
#define AT_MASK(S0, S1, kbase) do { \
        _Pragma("unroll") for (int i = 0; i < 16; ++i) { const int key = (kbase) + crow(i, hf); if (key > qrow) S0[i] = -1e30f; if (key + 32 > qrow) S1[i] = -1e30f; } } while (0)
#define AT_SMPV(S0, S1, Vb) do { \
        float mx = fmaxf(S0[0], S1[0]); \
        _Pragma("unroll") for (int i = 1; i < 16; ++i) mx = fmaxf(mx, fmaxf(S0[i], S1[i])); \
        mx = fmaxf(mx, __shfl_xor(mx, 32)); \
        const float mnew = fmaxf(mrun, mx), alpha = __builtin_amdgcn_exp2f(mrun - mnew); \
        float rs = 0.f; \
        _Pragma("unroll") for (int i = 0; i < 16; ++i) { S0[i] = __builtin_amdgcn_exp2f(S0[i] - mnew); S1[i] = __builtin_amdgcn_exp2f(S1[i] - mnew); rs += S0[i] + S1[i]; } \
        rs += __shfl_xor(rs, 32); \
        lrun = lrun * alpha + rs; mrun = mnew; \
        if (__builtin_amdgcn_ballot_w64(alpha != 1.0f)) { _Pragma("unroll") for (int i = 0; i < 16; ++i) { o0[i] *= alpha; o1[i] *= alpha; } } \
        _Pragma("unroll") for (int j4 = 0; j4 < 4; ++j4) { \
            const int kb = j4 >> 1, s_ = j4 & 1; u32x4 pw; \
            if (kb == 0) { pw.x = pk2(S0[8 * s_], S0[8 * s_ + 1]); pw.y = pk2(S0[8 * s_ + 2], S0[8 * s_ + 3]); pw.z = pk2(S0[8 * s_ + 4], S0[8 * s_ + 5]); pw.w = pk2(S0[8 * s_ + 6], S0[8 * s_ + 7]); } \
            else         { pw.x = pk2(S1[8 * s_], S1[8 * s_ + 1]); pw.y = pk2(S1[8 * s_ + 2], S1[8 * s_ + 3]); pw.z = pk2(S1[8 * s_ + 4], S1[8 * s_ + 5]); pw.w = pk2(S1[8 * s_ + 6], S1[8 * s_ + 7]); } \
            const bf16x8 pf = __builtin_bit_cast(bf16x8, pw); \
            const int koff = kb * 32 + 16 * s_ + 8 * hf; \
            const bf16x8 a0 = *(const bf16x8*)((Vb) + r * 72 + koff), a1 = *(const bf16x8*)((Vb) + (32 + r) * 72 + koff); \
            o0 = MFMA32(a0, pf, o0); o1 = MFMA32(a1, pf, o1); } } while (0)
    AT_LDK(ka0, ka1, 0); AT_LDV(va, 0); AT_STK(ka0, ka1, Kb0); AT_STV(va, Vb0);
    AT_LDK(ka0, ka1, 1); AT_STK(ka0, ka1, Kb1);
    AT_LDK(kb0, kb1, 2); AT_LDV(vb, 1);
    __syncthreads();
    f32x16 sa0, sa1, sb0, sb1;
    AT_QK(sa0, sa1, Kb0);
    __syncthreads();
    int t = 0;
#define AT_EVEN_TAIL() do { AT_STK(kb0, kb1, Kb0); AT_STV(vb, Vb1); __syncthreads(); } while (0)
#define AT_ODD_TAIL() do { AT_STK(ka0, ka1, Kb1); AT_STV(va, Vb0); __syncthreads(); } while (0)
#pragma unroll 1
    for (; t + 1 < tlw; t += 2) {
        AT_LDK(ka0, ka1, t + 3); AT_LDV(va, t + 2);
        AT_QK(sb0, sb1, Kb1);
        AT_SMPV(sa0, sa1, Vb0);
        AT_EVEN_TAIL();
        AT_LDK(kb0, kb1, t + 4); AT_LDV(vb, t + 3);
        AT_QK(sa0, sa1, Kb0);
        AT_SMPV(sb0, sb1, Vb1);
        AT_ODD_TAIL();
    }
    if (t < tlw) {
        AT_LDK(ka0, ka1, t + 3); AT_LDV(va, t + 2);
        AT_QK(sb0, sb1, Kb1);
        AT_SMPV(sa0, sa1, Vb0);
        AT_EVEN_TAIL();
        ++t;
        AT_LDK(kb0, kb1, t + 3); AT_LDV(vb, t + 2);
        if (masked) AT_MASK(sb0, sb1, (t0 + t) * 64);
        AT_SMPV(sb0, sb1, Vb1);
        AT_ODD_TAIL();
        ++t;
    } else {
        AT_LDK(ka0, ka1, t + 3); AT_LDV(va, t + 2);
        if (masked) AT_MASK(sa0, sa1, (t0 + t) * 64);
        AT_SMPV(sa0, sa1, Vb0);
        AT_EVEN_TAIL();
        ++t;
    }
#pragma unroll 1
    for (; t < ntiles; ++t) {
        if (t & 1) { AT_LDK(kb0, kb1, t + 3); AT_LDV(vb, t + 2); AT_ODD_TAIL(); } else { AT_LDK(ka0, ka1, t + 3); AT_LDV(va, t + 2); AT_EVEN_TAIL(); }
    }
#undef AT_EVEN_TAIL
#undef AT_ODD_TAIL
#undef AT_LDK
#undef AT_LDV
#undef AT_STK
#undef AT_STV
#undef AT_QK
#undef AT_MASK
#undef AT_SMPV
    if (qb < 16) {
        const float inv = 1.f / lrun;
        us* dst = mix + (size_t)qrow * DM + 640 + h * 64;
#pragma unroll
        for (int gq = 0; gq < 4; ++gq) {
            u32x2 w0, w1;
            w0.x = pk2(o0[4 * gq] * inv, o0[4 * gq + 1] * inv); w0.y = pk2(o0[4 * gq + 2] * inv, o0[4 * gq + 3] * inv);
            w1.x = pk2(o1[4 * gq] * inv, o1[4 * gq + 1] * inv); w1.y = pk2(o1[4 * gq + 2] * inv, o1[4 * gq + 3] * inv);
            *(u32x2*)(dst + 8 * gq + 4 * hf) = w0; *(u32x2*)(dst + 32 + 8 * gq + 4 * hf) = w1;
        }
    } else {
        const int slot = att_slot(h, qb, kc), rowl = wave * 32 + r;
        us* po = PO + att_slot_off(slot) + (size_t)rowl * 64;
#pragma unroll
        for (int gq = 0; gq < 4; ++gq) {
            u32x2 w0, w1;
            w0.x = pk2(o0[4 * gq], o0[4 * gq + 1]); w0.y = pk2(o0[4 * gq + 2], o0[4 * gq + 3]);
            w1.x = pk2(o1[4 * gq], o1[4 * gq + 1]); w1.y = pk2(o1[4 * gq + 2], o1[4 * gq + 3]);
            *(u32x2*)(po + 8 * gq + 4 * hf) = w0; *(u32x2*)(po + 32 + 8 * gq + 4 * hf) = w1;
        }
        if (hf == 0) { PML[((size_t)slot * 256 + rowl) * 2] = mrun; PML[((size_t)slot * 256 + rowl) * 2 + 1] = lrun; }
    }
}
DI void attn_merge(const us* PO, const float* PML, us* mix, int h, int qb) {
    int tid = threadIdx.x; asm volatile("" : "+v"(tid));
    const int row = tid >> 1, c0 = (tid & 1) * 32, nch = (qb >> 4) + 1;
    float mk[4], lk[4], M_ = -1e30f;
#pragma unroll
    for (int k = 0; k < 4; ++k) if (k < nch) { const size_t ix = ((size_t)att_slot(h, qb, k) * 256 + row) * 2; mk[k] = PML[ix]; lk[k] = PML[ix + 1]; M_ = fmaxf(M_, mk[k]); }
    float L = 0.f, wk[4];
#pragma unroll
    for (int k = 0; k < 4; ++k) if (k < nch) { wk[k] = __builtin_amdgcn_exp2f(mk[k] - M_); L += wk[k] * lk[k]; }
    const float inv = 1.f / L;
    f32x4 acc[8];
#pragma unroll
    for (int j = 0; j < 8; ++j) acc[j] = (f32x4){0.f, 0.f, 0.f, 0.f};
#pragma unroll
    for (int k = 0; k < 4; ++k) if (k < nch) { const us* po = PO + att_slot_off(att_slot(h, qb, k)) + (size_t)row * 64 + c0; const float w = wk[k] * inv;
#pragma unroll
        for (int j = 0; j < 4; ++j) { const u32x4 v = *(const u32x4*)(po + 8 * j);
            acc[2 * j] += (f32x4){__uint_as_float(v.x << 16), __uint_as_float(v.x & 0xffff0000u), __uint_as_float(v.y << 16), __uint_as_float(v.y & 0xffff0000u)} * w;
            acc[2 * j + 1] += (f32x4){__uint_as_float(v.z << 16), __uint_as_float(v.z & 0xffff0000u), __uint_as_float(v.w << 16), __uint_as_float(v.w & 0xffff0000u)} * w; } }
    us* dst = mix + (size_t)(qb * 256 + row) * DM + 640 + h * 64 + c0;
#pragma unroll
    for (int j = 0; j < 4; ++j) st_bf16x8(dst + 8 * j, acc[2 * j], acc[2 * j + 1]);
}
DI const void* ldp_g(const unsigned char* lds, int i, const unsigned char* gbase) {
    const volatile unsigned* t = (const volatile unsigned*)(lds + 131328) + 2 * i;
    const unsigned lo = __builtin_amdgcn_readfirstlane(t[0]), hi = __builtin_amdgcn_readfirstlane(t[1]);
    const long long off = (long long)((((unsigned long long)hi << 32) | lo) - (unsigned long long)gbase);
    return (const void*)(gbase + off);
}
#define LAS __attribute__((address_space(3)))
#define XB_TMO      128
#define XB_XCNT(j)  (256  + 64 * (j))
#define XB_XSUB(j)  (1280 + 64 * (j))
#define XB_XGEN(j)  (2304 + 64 * (j))
#define XB_TOP      3328
#define XB_TOPGEN   3392
#define XCD_BAR_WORDS 3456
#define XB_SPIN_CAP (1u << 18)

__device__ __forceinline__ unsigned xb_ld(unsigned* p)              { return __hip_atomic_load(p, __ATOMIC_RELAXED, __HIP_MEMORY_SCOPE_AGENT); }
__device__ __forceinline__ unsigned xb_add(unsigned* p, unsigned v) { return __hip_atomic_fetch_add(p, v, __ATOMIC_RELAXED, __HIP_MEMORY_SCOPE_AGENT); }
__device__ __forceinline__ unsigned xb_xcc_id() { return (unsigned)__builtin_amdgcn_s_getreg((3 << 11) | 20) & 0xFu; }
#define XB_SPIN(cond, bar) do { unsigned _sp = 0; while (cond) { __builtin_amdgcn_s_sleep(1); \
    if ((++_sp & 255u) == 0u) { if (xb_ld(&(bar)[XB_TMO])) break; if (_sp > XB_SPIN_CAP) { atomicAdd(&(bar)[XB_TMO], 1u); break; } } } } while (0)

struct XcdBarrier {
    unsigned* bar; unsigned x;
    volatile LAS unsigned* st;
};

__device__ __forceinline__ XcdBarrier xcd_barrier_post(unsigned* bar, volatile LAS unsigned* st) {
    XcdBarrier b; b.bar = bar; b.x = xb_xcc_id(); b.st = st;
    if (threadIdx.x == 0) (void)xb_add(&bar[XB_XCNT(b.x)], 1u);
    return b;
}
__device__ __forceinline__ void xcd_barrier_complete(unsigned* bar, unsigned x, unsigned& nloc, unsigned& nx) {
    const unsigned G = gridDim.x * gridDim.y * gridDim.z;
    unsigned sum, cnt, mine, sp = 0u;
    for (;;) {
        sum = 0u; cnt = 0u; mine = 0u;
#pragma unroll
        for (unsigned j = 0; j < 16; ++j) { const unsigned c = xb_ld(&bar[XB_XCNT(j)]); sum += c; cnt += (c > 0u) ? 1u : 0u; mine = (j == x) ? c : mine; }
        if (sum == G) break;
        __builtin_amdgcn_s_sleep(1);
        if ((++sp & 255u) == 0u) { if (xb_ld(&bar[XB_TMO])) break; if (sp > XB_SPIN_CAP) { atomicAdd(&bar[XB_TMO], 1u); break; } }
    }
    nloc = mine > 0u ? mine : 1u; nx = cnt > 0u ? cnt : 1u;
}

__device__ __forceinline__ void xcd_barrier(const XcdBarrier& b) {
    asm volatile("s_waitcnt vmcnt(0)" ::: "memory");
    __syncthreads();
    if (threadIdx.x == 0) {
        unsigned* bar = b.bar;
        __builtin_amdgcn_s_waitcnt(0);
        unsigned nloc = b.st[0], nx = b.st[1];
        if (nloc == 0u) { xcd_barrier_complete(bar, b.x, nloc, nx); b.st[0] = nloc; b.st[1] = nx; }
        const unsigned old = xb_add(&bar[XB_XSUB(b.x)], 1u);
        const unsigned gen = old / nloc;
        if (old + 1u == (gen + 1u) * nloc) {
            __builtin_amdgcn_fence(__ATOMIC_RELEASE, "agent");
            asm volatile("s_waitcnt vmcnt(0)" ::: "memory");
            const unsigned og = xb_add(&bar[XB_TOP], 1u);
            const unsigned tg = og / nx;
            if (og + 1u == (tg + 1u) * nx) xb_add(&bar[XB_TOPGEN], 1u);
            else XB_SPIN(xb_ld(&bar[XB_TOPGEN]) == tg, bar);
            __builtin_amdgcn_fence(__ATOMIC_ACQUIRE, "agent");
            xb_add(&bar[XB_XGEN(b.x)], 1u);
            asm volatile("s_waitcnt vmcnt(0)" ::: "memory");
        } else {
            XB_SPIN(xb_ld(&bar[XB_XGEN(b.x)]) == gen, bar);
            __builtin_amdgcn_fence(__ATOMIC_ACQUIRE, "agent");
            asm volatile("s_waitcnt vmcnt(0)" ::: "memory");
        }
    }
    __syncthreads();
}
constexpr int NTHR = 512;
#define XB_ST_OFF 131136
#define GSYNC() do { XcdBarrier xb_; xb_.bar = (unsigned*)(WSP + WS_CTL) + 1024; xb_.x = xb_xcc_id(); xb_.st = (volatile LAS unsigned*)(glds + XB_ST_OFF); xcd_barrier(xb_); } while (0)
#define INP(i) ((const float*)ldp_g(lds, (i), gbase))
#define OUTP ((float*)ldp_g(lds, 21, gbase))
#define WSP ((unsigned char*)ldp_g(lds, 22, gbase))

DI void conv_list_a(unsigned char* lds, const unsigned char* gbase, unsigned char* ws, int l, int wo_buf, int w0, int nw, int wave, int lane) {
    float* scr = (float*)(lds + wave * 8448);
    const float* w_in = INP(2) + (size_t)l * DM * DIN; const float* w_qb = INP(13) + (size_t)l * 384 * 576; const float* w_kvb = INP(15) + (size_t)l * 256 * 768; const float* w_out = INP(16) + (size_t)l * DM * DM;
    const float* g1 = INP(1) + l * DM; const float* gq = INP(12) + l * 384; const float* gkv = INP(14) + l * 256;
    us* Win_t = (us*)(ws + WS_WIN); us* Wqb_t = (us*)(ws + WS_WQB); us* Wkn_t = (us*)(ws + WS_WKN); us* Wv_t = (us*)(ws + WS_WV); us* Wout_t = (us*)(ws + (wo_buf ? WS_WOUT2 : WS_WOUT));
    constexpr int I_IN = 16 * 72, I_QB = 6 * 24, I_KN = 4 * 16, I_V = 4 * 16, I_OUT = 16 * 32, NIT = I_IN + I_QB + I_KN + I_V + I_OUT;
    for (int it = w0; it < NIT; it += nw) {
        int r = it;
        if (r < I_IN) { tr_item<1>(w_in, DM, DIN, Win_t, g1, scr, r, 72, lane); continue; } r -= I_IN;
        if (r < I_QB) { tr_item<2>(w_qb, 384, 576, Wqb_t, gq, scr, r, 24, lane); continue; } r -= I_QB;
        if (r < I_KN) { tr_item<3>(w_kvb, 256, 768, Wkn_t, gkv, scr, r, 16, lane); continue; } r -= I_KN;
        if (r < I_V) { tr_item<4>(w_kvb, 256, 768, Wv_t, gkv, scr, r, 16, lane); continue; } r -= I_V;
        tr_item_v4(w_out, DM, DM, Wout_t, nullptr, scr, r, 32, lane);
    }
}
DI void conv_list_b(unsigned char* lds, const unsigned char* gbase, unsigned char* ws, int l, int w0, int nw, int wave, int lane) {
    float* scr = (float*)(lds + wave * 8448);
    const float* w1 = INP(18) + (size_t)l * DM * FF; const float* w2 = INP(19) + (size_t)l * FF * DM; const float* g2 = INP(17) + l * DM;
    us* W1_t = (us*)(ws + WS_W1); us* W2_t = (us*)(ws + WS_W2);
    constexpr int I_1 = 16 * 128, I_2 = 64 * 32;
    for (int it = w0; it < I_1 + I_2; it += nw) {
        if (it < I_1) tr_item_v4(w1, DM, FF, W1_t, g2, scr, it, 128, lane);
        else tr_item_v4(w2, FF, DM, W2_t, nullptr, scr, it - I_1, 32, lane);
    }
}

__global__ void __launch_bounds__(NTHR, 2) fwd_megakernel(Params p) {
    extern __shared__ __attribute__((aligned(16))) unsigned char lds[];
    const int tid = threadIdx.x, lane = tid & 63, wave = __builtin_amdgcn_readfirstlane(tid >> 6);
    const int G = gridDim.x, bid = blockIdx.x, gw = bid * 8 + wave, NGW = G * 8;
    {
        unsigned long long* tab = (unsigned long long*)(lds + 131328);
        if (tid == 0) {
#pragma unroll
            for (int i = 0; i < 21; ++i) tab[i] = (unsigned long long)p.in[i];
            tab[21] = (unsigned long long)p.out; tab[22] = (unsigned long long)p.ws;
        }
        if (tid < 2) ((volatile unsigned*)(lds + XB_ST_OFF))[tid] = 0u;
        __syncthreads();
    }
    PG8_LAS unsigned char* glds = (PG8_LAS unsigned char*)lds;
    const unsigned char* gbase = p.ws;
    (void)xcd_barrier_post((unsigned*)(WSP + WS_CTL) + 1024, (volatile LAS unsigned*)(glds + XB_ST_OFF));

    {
        unsigned char* ws = WSP; float* ROPE = (float*)(ws + WS_ROPE);
        for (int idx = bid * NTHR + tid; idx < M * 16; idx += G * NTHR) {
            const int pos = idx >> 4, i = idx & 15;
            const float inv_freq = powf(10000.0f, -(float)i / 16.0f);
            const float ang = (float)pos * inv_freq;
            const double rev = (double)ang * 0.15915494309189535;
            const float fr = (float)(rev - rint(rev));
            ROPE[2 * idx] = __builtin_amdgcn_cosf(fr); ROPE[2 * idx + 1] = __builtin_amdgcn_sinf(fr);
        }
        conv_list_a(lds, gbase, ws, 0, 0, gw, NGW, wave, lane);
        x_to_bf16_ssq(INP(0), (us*)(ws + WS_XN), (float*)(ws + WS_SSQX), gw, NGW, lane);
    }
    if (gridDim.x == 0x7fffffffu) cg::this_grid().sync();
    GSYNC();

#pragma unroll 1
    for (int l = 0; l < NL; ++l) {
        {
            unsigned char* ws = WSP;
            pg8::Gemm g{(us*)(ws + WS_XN), (us*)(ws + WS_WIN), M, DINP, DM}; pg8::StaticOrder S; S.init(M, DINP, G, bid);
            EpiIn E{ws};
            prep_rstd(S, (const float*)(ws + WS_SSQX), (float*)(ws + WS_RSTD));
            pg8::gemm_phase<EpiIn, pg8::StaticOrder, true, true>(glds, g, S, E);
            __syncthreads();
            if (G > 64) { if (bid >= 64) conv_list_b(lds, gbase, ws, l, (bid - 64) * 8 + wave, (G - 64) * 8, wave, lane); }
            else conv_list_b(lds, gbase, ws, l, gw, NGW, wave, lane);
        }
        GSYNC();
        {
            unsigned char* ws = WSP;
            us* CQ = (us*)(ws + WS_CQ); us* CKV = (us*)(ws + WS_CKV); us* Q = (us*)(ws + WS_Q); us* K = (us*)(ws + WS_K); us* VT = (us*)(ws + WS_VT);
            float* SSQ = (float*)(ws + WS_SSQ); float* ROPE = (float*)(ws + WS_ROPE);
            { pg8::Gemm g{CQ, (us*)(ws + WS_WQB), M, 768, 384}; pg8::StaticOrder S; S.init(M, 768, G, bid); EpiQ E{Q, SSQ, ROPE}; pg8::gemm_phase<EpiQ, pg8::StaticOrder, true, true>(glds, g, S, E); }
            __syncthreads();
            { pg8::Gemm g{CKV, (us*)(ws + WS_WKN), M, 512, 256}; pg8::StaticOrder S; S.init(M, 512, G, (bid + 64) % G); EpiKn E{K, SSQ}; pg8::gemm_phase<EpiKn, pg8::StaticOrder, true, true>(glds, g, S, E); }
            __syncthreads();
            { pg8::Gemm g{(us*)(ws + WS_WV), CKV, 512, M, 256}; pg8::StaticOrder S; S.init(512, M, G, (bid + 192) % G); EpiVt E{VT, SSQ}; pg8::gemm_phase<EpiVt, pg8::StaticOrder, true, true>(glds, g, S, E); }
            __syncthreads();
            const float* cw = INP(6) + (size_t)l * 4 * 640; const float* cb = INP(7) + l * 640;
            for (int it = bid; it < 256; it += G)
                ssd_item(lds, it >> 1, it & 1, (us*)(ws + WS_XBC), (float*)(ws + WS_DT), cw, cb, INP(8) + l * 6, INP(9) + l * 6, INP(10) + l * 6,
                         (us*)OUTP  , (float*)(ws + WS_ST), (float*)(ws + WS_ACUM), (float*)(ws + WS_DEC), (us*)(ws + WS_CC));
            for (int it = bid; it < 512; it += G)
                gmlp_item(lds, it >> 2, it & 3, (us*)(ws + WS_U), (us*)(ws + WS_V), SSQ, INP(3) + l * 256, INP(4) + (size_t)l * 4 * 128 * 128, INP(5) + l * 4 * 128, (us*)(ws + WS_MIX));
        }
        GSYNC();
        {
            unsigned char* ws = WSP;
            float* ST = (float*)(ws + WS_ST); const float* DEC = (const float*)(ws + WS_DEC);
            int tl = threadIdx.x; asm volatile("" : "+v"(tl)); const int idx = bid * NTHR + tl;
            if (idx < 6 * 4096) {
                const int h = idx >> 12, pn = idx & 4095; float hs = 0.f;
#pragma unroll 1
                for (int c0 = 0; c0 < 128; c0 += 16) {
                    float tmp[16], dc[16];
#pragma unroll
                    for (int j = 0; j < 16; ++j) { tmp[j] = ST[((size_t)(c0 + j) * 6 + h) * 4096 + pn]; dc[j] = DEC[(c0 + j) * 8 + h]; }
#pragma unroll
                    for (int j = 0; j < 16; ++j) { ST[((size_t)(c0 + j) * 6 + h) * 4096 + pn] = hs; hs = dc[j] * hs + tmp[j]; }
                }
            }
            volatile unsigned* slot = (volatile unsigned*)(lds + 131200);
            {
            unsigned* qctr = (unsigned*)(ws + WS_CTL) + 64 * l;
            for (;;) {
                if (tid == 0) slot[0] = atomicAdd(qctr, 1u);
                __syncthreads();
                const unsigned uu = (unsigned)__builtin_amdgcn_readfirstlane((int)slot[0]);
                __syncthreads();
                if (uu >= (unsigned)ATT_ITEMS) break;
                int ah, aqb, akc; att_decode((int)uu, ah, aqb, akc);
                attn_unit(lds, (us*)(ws + WS_Q), (us*)(ws + WS_K), (us*)(ws + WS_VT), (us*)(ws + WS_MIX), (us*)(ws + 124 * MiB), (float*)(ws + 162 * MiB), ah, aqb, akc);
            }
            }
        }
        GSYNC();
        {
            unsigned char* ws = WSP;
            for (int it = bid; it < 288; it += G) attn_merge((const us*)(ws + 124 * MiB), (const float*)(ws + 162 * MiB), (us*)(ws + WS_MIX), it % 6, 16 + it / 6);
            for (int it = bid; it < 256; it += G)
                ssd_final_item(lds, it >> 1, it & 1, (us*)(ws + WS_CC), (float*)(ws + WS_ST), (us*)OUTP  , (float*)(ws + WS_ACUM), (us*)(ws + WS_ZS), INP(11) + l * 384, (us*)(ws + WS_MIX));
            if (l + 1 < NL) {
                if (G > 32) { if (bid >= 32) conv_list_a(lds, gbase, ws, l + 1, (l + 1) & 1, (bid - 32) * 8 + wave, (G - 32) * 8, wave, lane); }
                else conv_list_a(lds, gbase, ws, l + 1, (l + 1) & 1, gw, NGW, wave, lane);
            }
        }
        GSYNC();
        {
            unsigned char* ws = WSP;
            pg8::Gemm g{(us*)(ws + WS_MIX), (us*)(ws + ((l & 1) ? WS_WOUT2 : WS_WOUT)), M, DM, DM}; pg8::StaticOrder S; S.init(M, DM, G, bid);
            EpiRes E{(us*)(ws + WS_XN), (float*)(ws + WS_SSQX)};
            pg8::gemm_phase<EpiRes, pg8::StaticOrder, true, true>(glds, g, S, E);
        }
        GSYNC();
        {
            unsigned char* ws = WSP;
            pg8::Gemm g{(us*)(ws + WS_XN), (us*)(ws + WS_W1), M, FF, DM}; pg8::StaticOrder S; S.init(M, FF, G, bid); EpiRelu2 E{(us*)(ws + WS_H), (const float*)(ws + WS_RSTD)};
            prep_rstd(S, (const float*)(ws + WS_SSQX), (float*)(ws + WS_RSTD));
            pg8::gemm_phase<EpiRelu2, pg8::StaticOrder, true, true>(glds, g, S, E);
        }
        GSYNC();
        {
            unsigned char* ws = WSP;
            pg8::Gemm g{(us*)(ws + WS_H), (us*)(ws + WS_W2), M, DM, FF}; pg8::StaticOrder S; S.init(M, DM, G, bid);
            EpiRes E{(us*)(ws + WS_XN), (float*)(ws + WS_SSQX)};
            pg8::gemm_phase<EpiRes, pg8::StaticOrder, true, true>(glds, g, S, E);
        }
        GSYNC();
    }
    norm_rows_out((const us*)(WSP + WS_XN), OUTP, INP(20), gw, NGW, lane);
}

extern "C" void kernel_launch(void* const* d_in, const int* in_sizes, int n_in, void* d_out, int out_size, void* d_ws, size_t ws_size, hipStream_t stream) {
    static int grid = 0;
    if (grid == 0) {
        if (n_in != 21 || out_size != M * DM || ws_size < WS_END) { fprintf(stderr, "kernel_launch: unexpected shapes (n_in %d out %d ws %zu)\n", n_in, out_size, ws_size); grid = -1; return; }
        int dev = 0, cus = 0, per_cu = 0;
        (void)hipGetDevice(&dev); (void)hipDeviceGetAttribute(&cus, hipDeviceAttributeMultiprocessorCount, dev);
        (void)hipFuncSetAttribute((const void*)fwd_megakernel, hipFuncAttributeMaxDynamicSharedMemorySize, LDS_BYTES);
        (void)hipOccupancyMaxActiveBlocksPerMultiprocessor(&per_cu, (const void*)fwd_megakernel, NTHR, LDS_BYTES);
        if (per_cu < 1) { fprintf(stderr, "kernel_launch: occupancy query says %d blocks per CU\n", per_cu); per_cu = 1; }
        (void)hipGetLastError();
        grid = cus * per_cu;
    }
    if (grid < 0) return;
    (void)hipMemsetAsync((char*)d_ws + WS_CTL, 0, 32768, stream);
    Params p{};
    for (int i = 0; i < 21; ++i) p.in[i] = (const float*)d_in[i];
    p.out = (float*)d_out; p.ws = (unsigned char*)d_ws;
    void* args[] = {&p};
    hipError_t e = hipLaunchCooperativeKernel((const void*)fwd_megakernel, dim3(grid), dim3(NTHR), args, LDS_BYTES, stream);
    if (e != hipSuccess) fprintf(stderr, "cooperative launch failed: %s (grid %d)\n", hipGetErrorString(e), grid);
}
```

```cpp
#include <hip/hip_runtime.h>
#include <hip/hip_cooperative_groups.h>
#include <cstdio>
#include <cstdint>
namespace cg = cooperative_groups;
namespace pg8 {
#define PG8_LAS __attribute__((address_space(3)))
typedef unsigned short bf16_t;
typedef short bf16x8 __attribute__((ext_vector_type(8)));
typedef float f32x4 __attribute__((ext_vector_type(4)));
typedef unsigned u32x4 __attribute__((ext_vector_type(4)));
constexpr int BM = 256, BK = 64, HALF = 128, HTB = HALF * BK * 2  , STAGE_BYTES = 8 * HTB, NXCD = 8, WGM = 8;

__host__ __device__ __forceinline__ int lds_byte(int r, int c) { const int st = (r >> 4) * 2 + (c >> 5), rr = r & 15, cc = c & 31, ob = rr * 64 + cc * 2; return st * 1024 + (ob ^ (((ob >> 9) & 1) << 5)); }
__host__ __device__ __forceinline__ void stage_rc(int b, int& R, int& C) { const int st = b / 1024, sb = b % 1024, swz = sb ^ (((sb >> 9) & 1) << 5); R = (st >> 1) * 16 + swz / 64; C = (st & 1) * 32 + (swz % 64) / 2; }
__host__ __device__ __forceinline__ int perm32(int rho) { const int n = rho >> 4, i = rho & 15; return 8 * (i >> 2) + 4 * n + (i & 3); }

struct Unit { int pm, pn; };
struct Gemm { const bf16_t* A; const bf16_t* Bt; int M, N, K; };

struct StaticOrder {
    int nM, nN, nwg, G, c;
    __host__ __device__ void init(int M, int N, int G_, int c_) { nM = M / BM; nN = N / BM; nwg = nM * nN; G = G_; c = c_; }
    __host__ __device__ bool next(int i, Unit& u) const {
        const long L = (long)i * G + c; if (L >= nwg) return false;
        int wgid = (int)L; { const int q = nwg / NXCD, r = nwg % NXCD, xcd = wgid % NXCD, off = wgid / NXCD; wgid = (xcd < r ? xcd * (q + 1) : r * (q + 1) + (xcd - r) * q) + off; }
        const int nig = WGM * nN, gid = wgid / nig, fm = gid * WGM, gsz = (nM - fm) < WGM ? (nM - fm) : WGM;
        u.pm = fm + ((wgid % nig) % gsz); u.pn = (wgid % nig) / gsz; return true;
    }
    __device__ __forceinline__ void a_ready(const Unit&) const {}
    __device__ __forceinline__ void done(const Unit&) const {}
};

__device__ __forceinline__ unsigned cvt_pk_bf16(float lo, float hi) { unsigned r; asm volatile("v_cvt_pk_bf16_f32 %0, %1, %2" : "=v"(r) : "v"(lo), "v"(hi)); return r; }
template <class Epi, class Sched, bool ALIGN_EPI = false, bool SP2 = false>
__device__ __forceinline__ void gemm_phase(PG8_LAS unsigned char* lds, const Gemm g, const Sched& S, const Epi& E) {
    int tid_l = threadIdx.x; asm volatile("" : "+v"(tid_l));
    const int tid = tid_l, wid = __builtin_amdgcn_readfirstlane(tid >> 6), lane = tid & 63, wr = wid >> 2, wc = wid & 3, fr = lane & 15, fq = lane >> 4;
    int K_l = g.K; asm volatile("" : "+s"(K_l));
    const int K = K_l, nt = K / BK;
    unsigned voffA[2], voffB[2];
#pragma unroll
    for (int i = 0; i < 2; ++i) { int R, C; stage_rc(tid * 16 + i * 8192, R, C); const int Rb = Epi::PERM ? ((R & ~31) + perm32(R & 31)) : R;
        voffA[i] = (unsigned)(R * K + C) * 2u; voffB[i] = (unsigned)(Rb * K + C) * 2u; }
    const size_t kstep = (size_t)(BK * 2);
    const size_t hstep = (size_t)HALF * K * 2;
    const size_t tstep = 2 * hstep;
    const unsigned ldsw = (unsigned)wid * 1024u;
    const int aoff = lds_byte(wr * 64 + fr, fq * 8), boff = lds_byte(wc * 32 + fr, fq * 8);
#define PG8_SA(b, h) (((b) * 2 + (h)) * HTB)
#define PG8_SB(b, h) ((4 + (b) * 2 + (h)) * HTB)
#define PG8_STAGE(bufoff, gbase, voff) do { _Pragma("unroll") for (int _i = 0; _i < 2; ++_i) \
        __builtin_amdgcn_global_load_lds((const unsigned*)((const char*)(gbase) + (voff)[_i]), (PG8_LAS unsigned*)(lds + (bufoff) + ldsw + _i * 8192), 16, 0, 0); } while (0)
#define PG8_LDA(dst, b, h) do { _Pragma("unroll") for (int m = 0; m < 4; ++m) _Pragma("unroll") for (int k = 0; k < 2; ++k) dst[m][k] = *(const PG8_LAS bf16x8*)(lds + PG8_SA(b, h) + aoff + m * 2048 + k * 1024); } while (0)
#define PG8_LDB(dst, b, h) do { _Pragma("unroll") for (int n = 0; n < 2; ++n) _Pragma("unroll") for (int k = 0; k < 2; ++k) dst[n][k] = *(const PG8_LAS bf16x8*)(lds + PG8_SB(b, h) + boff + n * 2048 + k * 1024); } while (0)
#define PG8_MMA(ai, bj, At, Bt) do { __builtin_amdgcn_s_setprio(1); _Pragma("unroll") for (int m = 0; m < 4; ++m) _Pragma("unroll") for (int n = 0; n < 2; ++n) _Pragma("unroll") for (int k = 0; k < 2; ++k) \
        acc[ai][bj][m][n] = __builtin_amdgcn_mfma_f32_16x16x32_bf16(Bt[n][k], At[m][k], acc[ai][bj][m][n], 0, 0, 0); __builtin_amdgcn_s_setprio(0); } while (0)
#define PG8_WAIT_V(n) asm volatile("s_waitcnt vmcnt(" #n ")" ::: "memory")
#define PG8_WAIT_L(n) asm volatile("s_waitcnt lgkmcnt(" #n ")" ::: "memory")
#define PG8_BAR __builtin_amdgcn_s_barrier()
#define PG8_SCHED __builtin_amdgcn_sched_barrier(0)
    Unit cur, nxt; int ui = 0;
    if (!S.next(0, cur)) return;
    f32x4 acc[2][2][4][2];
#pragma unroll
    for (int a = 0; a < 2; ++a)
#pragma unroll
        for (int b = 0; b < 2; ++b)
#pragma unroll
            for (int m = 0; m < 4; ++m)
#pragma unroll
                for (int n = 0; n < 2; ++n) acc[a][b][m][n] = (f32x4){0.f, 0.f, 0.f, 0.f};
    bf16x8 At[4][2], B0[2][2], B1[2][2];
    const char* cA = (const char*)g.A + (size_t)cur.pm * tstep; const char* cB = (const char*)g.Bt + (size_t)cur.pn * tstep;
    S.a_ready(cur);
    if constexpr (SP2) {
        PG8_STAGE(PG8_SB(0, 0), cB, voffB); PG8_STAGE(PG8_SB(0, 1), cB + hstep, voffB); PG8_STAGE(PG8_SA(0, 0), cA, voffA); PG8_STAGE(PG8_SA(0, 1), cA + hstep, voffA);
        if (wr == 1) PG8_BAR;
        PG8_WAIT_V(2); PG8_BAR;
        PG8_STAGE(PG8_SB(1, 0), cB + kstep, voffB); PG8_STAGE(PG8_SA(1, 0), cA + kstep, voffA); PG8_STAGE(PG8_SB(1, 1), cB + hstep + kstep, voffB);
        PG8_WAIT_V(6); PG8_BAR;
    } else {
        PG8_STAGE(PG8_SB(0, 0), cB, voffB); PG8_STAGE(PG8_SA(0, 0), cA, voffA); PG8_STAGE(PG8_SB(0, 1), cB + hstep, voffB); PG8_STAGE(PG8_SA(0, 1), cA + hstep, voffA);
        if (wr == 1) PG8_BAR;
        PG8_WAIT_V(4); PG8_BAR;
        PG8_STAGE(PG8_SB(1, 0), cB + kstep, voffB); PG8_STAGE(PG8_SA(1, 0), cA + kstep, voffA); PG8_STAGE(PG8_SB(1, 1), cB + hstep + kstep, voffB);
        PG8_WAIT_V(6); PG8_BAR;
    }
    for (;;) {
        const bool has_next = S.next(ui + 1, nxt);
        const char* nA = has_next ? (const char*)g.A + (size_t)nxt.pm * tstep : cA; const char* nB = has_next ? (const char*)g.Bt + (size_t)nxt.pn * tstep : cB;
        for (int t = 0; t < nt; t += 2) {
            const bool last = (t == nt - 2);
            const char* a1 = cA + (size_t)(t + 1) * kstep;
            const char* a2 = last ? nA : cA + (size_t)(t + 2) * kstep; const char* b2 = last ? nB : cB + (size_t)(t + 2) * kstep;
            const char* a3 = a2 + kstep; const char* b3 = b2 + kstep;
            if (last && has_next) S.a_ready(nxt);
            if constexpr (SP2) {
            PG8_LDB(B0, 0, 0); PG8_LDB(B1, 0, 1); PG8_SCHED; PG8_LDA(At, 0, 0); PG8_STAGE(PG8_SA(1, 1), a1 + hstep, voffA);
            PG8_WAIT_V(8); PG8_WAIT_L(0); PG8_BAR; PG8_MMA(0, 0, At, B0); PG8_MMA(0, 1, At, B1); PG8_BAR; PG8_SCHED;
            PG8_LDA(At, 0, 1); PG8_STAGE(PG8_SB(0, 0), b2, voffB); PG8_STAGE(PG8_SB(0, 1), b2 + hstep, voffB); PG8_STAGE(PG8_SA(0, 0), a2, voffA);
            PG8_WAIT_V(8); PG8_WAIT_L(0); PG8_BAR; PG8_MMA(1, 0, At, B0); PG8_MMA(1, 1, At, B1); PG8_BAR; PG8_SCHED;
            PG8_LDB(B0, 1, 0); PG8_LDB(B1, 1, 1); PG8_SCHED; PG8_LDA(At, 1, 0); PG8_STAGE(PG8_SA(0, 1), a2 + hstep, voffA);
            PG8_WAIT_V(8); PG8_WAIT_L(0); PG8_BAR; PG8_MMA(0, 0, At, B0); PG8_MMA(0, 1, At, B1); PG8_BAR; PG8_SCHED;
            PG8_LDA(At, 1, 1); PG8_STAGE(PG8_SB(1, 0), b3, voffB); PG8_STAGE(PG8_SB(1, 1), b3 + hstep, voffB); PG8_STAGE(PG8_SA(1, 0), a3, voffA);
            PG8_WAIT_V(8); PG8_WAIT_L(0); PG8_BAR; PG8_MMA(1, 0, At, B0); PG8_MMA(1, 1, At, B1); PG8_BAR; PG8_SCHED;
            } else {
            PG8_LDB(B0, 0, 0); PG8_SCHED; PG8_LDA(At, 0, 0); PG8_STAGE(PG8_SA(1, 1), a1 + hstep, voffA);
            PG8_WAIT_L(8); PG8_BAR; PG8_WAIT_L(0); PG8_MMA(0, 0, At, B0); PG8_BAR; PG8_SCHED;
            PG8_LDB(B1, 0, 1); PG8_STAGE(PG8_SB(0, 0), b2, voffB);
            PG8_BAR; PG8_WAIT_L(0); PG8_MMA(0, 1, At, B1); PG8_BAR;
            PG8_LDA(At, 0, 1); PG8_STAGE(PG8_SA(0, 0), a2, voffA);
            PG8_BAR; PG8_WAIT_L(0); PG8_MMA(1, 0, At, B0); PG8_BAR; PG8_SCHED;
            PG8_STAGE(PG8_SB(0, 1), b2 + hstep, voffB);
            PG8_WAIT_V(6); PG8_BAR; PG8_MMA(1, 1, At, B1); PG8_BAR;
            PG8_LDB(B0, 1, 0); PG8_SCHED; PG8_LDA(At, 1, 0); PG8_STAGE(PG8_SA(0, 1), a2 + hstep, voffA);
            PG8_WAIT_L(8); PG8_BAR; PG8_WAIT_L(0); PG8_MMA(0, 0, At, B0); PG8_BAR; PG8_SCHED;
            PG8_LDB(B1, 1, 1); PG8_STAGE(PG8_SB(1, 0), b3, voffB);
            PG8_BAR; PG8_WAIT_L(0); PG8_MMA(0, 1, At, B1); PG8_BAR;
            PG8_LDA(At, 1, 1); PG8_STAGE(PG8_SA(1, 0), a3, voffA);
            PG8_BAR; PG8_WAIT_L(0); PG8_MMA(1, 0, At, B0); PG8_BAR; PG8_SCHED;
            PG8_STAGE(PG8_SB(1, 1), b3 + hstep, voffB);
            PG8_WAIT_V(6); PG8_BAR; PG8_MMA(1, 1, At, B1); PG8_BAR;
            }
        }
        if constexpr (ALIGN_EPI) { if (wr == 0) PG8_BAR; }
        if constexpr (!Epi::AFTER_DRAIN) { E(acc, cur, wr, wc, fr, fq); S.done(cur); }
        if (!has_next) break;
#pragma unroll
        for (int a = 0; a < 2; ++a)
#pragma unroll
            for (int b = 0; b < 2; ++b)
#pragma unroll
                for (int m = 0; m < 4; ++m)
#pragma unroll
                    for (int n = 0; n < 2; ++n) acc[a][b][m][n] = (f32x4){0.f, 0.f, 0.f, 0.f};
        cur = nxt; cA = nA; cB = nB; ++ui;
        if constexpr (ALIGN_EPI) { if (wr == 1) PG8_BAR; }
    }
    PG8_WAIT_V(0);
    if constexpr (!ALIGN_EPI) { if (wr == 0) PG8_BAR; }
    PG8_BAR;
    if constexpr (Epi::AFTER_DRAIN) { E.fused(acc, cur, wr, wc, fr, fq, lds, wid, lane); S.done(cur); }
#undef PG8_SA
#undef PG8_SB
#undef PG8_STAGE
#undef PG8_LDA
#undef PG8_LDB
#undef PG8_MMA
#undef PG8_WAIT_V
#undef PG8_WAIT_L
#undef PG8_BAR
#undef PG8_SCHED
}
}

#ifndef PG8_SP2
#define PG8_SP2 true
#endif
#ifndef PG8_ALIGN
#define PG8_ALIGN true
#endif
#define DI __device__ __forceinline__
typedef unsigned short us;
typedef short bf16x8 __attribute__((ext_vector_type(8)));
typedef short s16x4 __attribute__((ext_vector_type(4)));
typedef float f32x4 __attribute__((ext_vector_type(4)));
typedef float f32x16 __attribute__((ext_vector_type(16)));
typedef unsigned u32x4 __attribute__((ext_vector_type(4)));
typedef unsigned u32x2 __attribute__((ext_vector_type(2)));
#define MFMA32(a, b, c) __builtin_amdgcn_mfma_f32_32x32x16_bf16((a), (b), (c), 0, 0, 0)

constexpr int M = 16384, DM = 1024, NL = 4, FF = 4096, DINP = 2304, DIN = 2214;
constexpr float EPS = 1e-6f;
constexpr size_t MiB = 1u << 20;
constexpr size_t WS_CTL = 0, WS_ROPE = 1 * MiB, WS_SSQ = 3 * MiB, WS_DT = 5 * MiB, WS_ACUM = 5 * MiB + 512 * 1024, WS_DEC = 6 * MiB;
constexpr size_t WS_WIN = 8 * MiB, WS_WQB = 12 * MiB + 512 * 1024, WS_WKN = 13 * MiB + 256 * 1024, WS_WV = 13 * MiB + 512 * 1024, WS_WOUT = 14 * MiB, WS_W1 = 16 * MiB, WS_W2 = 24 * MiB;
constexpr size_t WS_XN = 32 * MiB, WS_Y = 32 * MiB  , WS_MIX = 64 * MiB, WS_H = 96 * MiB;
constexpr size_t WS_U = 96 * MiB, WS_V = 104 * MiB, WS_ZS = 112 * MiB, WS_XBC = 124 * MiB, WS_CQ = 144 * MiB, WS_CKV = 156 * MiB, WS_Q = 164 * MiB, WS_K = 182 * MiB, WS_VT = 200 * MiB, WS_CC = 212 * MiB;
constexpr size_t WS_ST = 224 * MiB, WS_SSQX = 236 * MiB, WS_WOUT2 = 238 * MiB, WS_RSTD = 240 * MiB, WS_END = 241 * MiB;
constexpr int LDS_BYTES = 147456;
constexpr float QSCALE = 0.10206207261596575f * 1.4426950408889634f;

DI float bf2f(us b) { return __uint_as_float(((unsigned)b) << 16); }
typedef __bf16 bf16x2_t __attribute__((ext_vector_type(2)));
typedef float f32x2_t __attribute__((ext_vector_type(2)));
DI unsigned pk2(float lo, float hi) { f32x2_t v = {lo, hi}; bf16x2_t b = __builtin_convertvector(v, bf16x2_t); return __builtin_bit_cast(unsigned, b); }
DI us f2bf(float f) { return (us)(pk2(f, 0.f) & 0xffffu); }
DI int crow(int i, int hf) { return (i & 3) + 8 * (i >> 2) + 4 * hf; }
DI float wave_sum(float v) {
#pragma unroll
    for (int o = 1; o < 64; o <<= 1) v += __shfl_xor(v, o);
    return v;
}
DI float gelu_tanh(float x) { const float u = 0.7978845608028654f * (x + 0.044715f * x * x * x); return x * __builtin_amdgcn_rcpf(1.f + __builtin_amdgcn_exp2f(-2.885390081777927f * u)); }
DI float silu(float x) { return x * __builtin_amdgcn_rcpf(1.f + __builtin_amdgcn_exp2f(-1.4426950408889634f * x)); }
DI float softplus(float x) { return x > 20.f ? x : log1pf(__expf(x)); }
DI int rope_src(int j) { const int g = j >> 3, w = j & 7, i = g * 4 + (w & 3); return (w < 4) ? i : 16 + i; }
#define LDS_WAIT() asm volatile("s_waitcnt lgkmcnt(0)" ::: "memory")

DI void mm32(f32x16& acc, const us* A, int lda, const us* B, int ldb, int ksteps, int lane) {
    const int r = lane & 31, hf = lane >> 5;
    const us* ap = A + r * lda + 8 * hf; const us* bp = B + r * ldb + 8 * hf;
    for (int ks = 0; ks < ksteps; ++ks) { const bf16x8 a = *(const bf16x8*)(ap + 16 * ks); const bf16x8 b = *(const bf16x8*)(bp + 16 * ks); acc = MFMA32(a, b, acc); }
}

struct Params { const float* in[21]; float* out; unsigned char* ws; };

template <int MODE> DI int src_col(int r) {
    if (MODE == 0) return r;
    if (MODE == 1) { if (r < 1536) return r; if (r < 2176) return r + 6; if (r < 2208) return 2182 + rope_src(r - 2176); if (r < 2214) return 1536 + (r - 2208); return -1; }
    if (MODE == 2) { if (r >= 576) return -1; const int hd = r / 96, w = r % 96; return w < 64 ? r : hd * 96 + 64 + rope_src(w - 64); }
    if (MODE == 3) { if (r >= 384) return -1; return (r >> 6) * 128 + (r & 63); }
    if (r >= 384) return -1; return (r >> 6) * 128 + 64 + (r & 63);
}
template <int MODE> DI void tr_item(const float* __restrict__ W, int K, int Nsrc, us* WT, const float* gk, float* scr, int item, int nblk, int lane) {
    asm volatile("" : "+v"(lane));
    const int kb = item / nblk, nb = item % nblk, k0 = 64 * kb, n0 = 32 * nb;
    const int sc = src_col<MODE>(n0 + (lane & 31));
#pragma unroll 16
    for (int i = 0; i < 32; ++i) { const int kk = 2 * i + (lane >> 5); float v = sc >= 0 ? W[(size_t)(k0 + kk) * Nsrc + sc] : 0.f; if (gk) v *= gk[k0 + kk]; scr[kk * 33 + (lane & 31)] = v; }
    LDS_WAIT();
    const int c = lane & 7;
#pragma unroll
    for (int j = 0; j < 4; ++j) { const int n = (lane >> 3) + 8 * j; const float* s = scr + (8 * c) * 33 + n;
        u32x4 o; o.x = pk2(s[0 * 33], s[1 * 33]); o.y = pk2(s[2 * 33], s[3 * 33]); o.z = pk2(s[4 * 33], s[5 * 33]); o.w = pk2(s[6 * 33], s[7 * 33]);
        *(u32x4*)(WT + (size_t)(n0 + n) * K + k0 + 8 * c) = o; }
    LDS_WAIT();
}

DI void tr_item_v4(const float* __restrict__ W, int K, int N, us* WT, const float* gk, float* scr, int item, int nblk, int lane) {
    asm volatile("" : "+v"(lane));
    const int kb = item / nblk, nb = item % nblk, k0 = 64 * kb, n0 = 32 * nb, kr = lane >> 3, n4 = 4 * (lane & 7);
    f32x4 v[8];
#pragma unroll
    for (int j = 0; j < 8; ++j) v[j] = *(const f32x4*)(W + (size_t)(k0 + 8 * j + kr) * N + n0 + n4);
#pragma unroll
    for (int j = 0; j < 8; ++j) { const int kk = 8 * j + kr; const float gsc = gk ? gk[k0 + kk] : 1.f;
        scr[kk * 33 + n4] = v[j][0] * gsc; scr[kk * 33 + n4 + 1] = v[j][1] * gsc; scr[kk * 33 + n4 + 2] = v[j][2] * gsc; scr[kk * 33 + n4 + 3] = v[j][3] * gsc; }
    LDS_WAIT();
    const int c = lane & 7;
#pragma unroll
    for (int j = 0; j < 4; ++j) { const int n = (lane >> 3) + 8 * j; const float* s = scr + (8 * c) * 33 + n;
        u32x4 o; o.x = pk2(s[0 * 33], s[1 * 33]); o.y = pk2(s[2 * 33], s[3 * 33]); o.z = pk2(s[4 * 33], s[5 * 33]); o.w = pk2(s[6 * 33], s[7 * 33]);
        *(u32x4*)(WT + (size_t)(n0 + n) * K + k0 + 8 * c) = o; }
    LDS_WAIT();
}

DI void norm_rows_bf16(const float* x, const float* g, us* XN, int gw, int NGW, int lane) {
    asm volatile("" : "+v"(lane));
    f32x4 gv[4];
#pragma unroll
    for (int j = 0; j < 4; ++j) gv[j] = *(const f32x4*)(g + 4 * lane + 256 * j);
    for (int m = gw; m < M; m += NGW) {
        const f32x4* xr = (const f32x4*)(x + (size_t)m * DM) + lane;
        f32x4 v[4]; float s = 0.f;
#pragma unroll
        for (int j = 0; j < 4; ++j) { v[j] = xr[64 * j]; s += (v[j].x * v[j].x + v[j].y * v[j].y) + (v[j].z * v[j].z + v[j].w * v[j].w); }
        const float rstd = rsqrtf(wave_sum(s) * (1.f / DM) + EPS);
        u32x2* o = (u32x2*)(XN + (size_t)m * DM) + lane;
#pragma unroll
        for (int j = 0; j < 4; ++j) { u32x2 w; w.x = pk2(v[j].x * rstd * gv[j].x, v[j].y * rstd * gv[j].y); w.y = pk2(v[j].z * rstd * gv[j].z, v[j].w * rstd * gv[j].w); o[64 * j] = w; }
    }
}
DI void x_to_bf16_ssq(const float* x, us* XB, float* SSQX, int gw, int NGW, int lane) {
    asm volatile("" : "+v"(lane));
    for (int m = gw; m < M; m += NGW) {
        const f32x4* xr = (const f32x4*)(x + (size_t)m * DM) + lane;
        f32x4 v[4]; float s = 0.f;
#pragma unroll
        for (int j = 0; j < 4; ++j) { v[j] = xr[64 * j]; s += (v[j].x * v[j].x + v[j].y * v[j].y) + (v[j].z * v[j].z + v[j].w * v[j].w); }
        s = wave_sum(s);
        u32x2* o = (u32x2*)(XB + (size_t)m * DM) + lane;
#pragma unroll
        for (int j = 0; j < 4; ++j) { u32x2 w; w.x = pk2(v[j].x, v[j].y); w.y = pk2(v[j].z, v[j].w); o[64 * j] = w; }
        if (lane < 32) SSQX[m * 32 + lane] = lane == 0 ? s : 0.f;
    }
}
DI void norm_rows_out(const us* xb, float* out, const float* g, int gw, int NGW, int lane) {
    asm volatile("" : "+v"(lane));
    f32x4 gv[4];
#pragma unroll
    for (int j = 0; j < 4; ++j) gv[j] = *(const f32x4*)(g + 4 * lane + 256 * j);
    for (int m = gw; m < M; m += NGW) {
        const u32x2* xr = (const u32x2*)(xb + (size_t)m * DM) + lane;
        f32x4 v[4]; float s = 0.f;
#pragma unroll
        for (int j = 0; j < 4; ++j) { const u32x2 w = xr[64 * j]; v[j] = (f32x4){__uint_as_float(w.x << 16), __uint_as_float(w.x & 0xffff0000u), __uint_as_float(w.y << 16), __uint_as_float(w.y & 0xffff0000u)};
            s += (v[j].x * v[j].x + v[j].y * v[j].y) + (v[j].z * v[j].z + v[j].w * v[j].w); }
        const float rstd = rsqrtf(wave_sum(s) * (1.f / DM) + EPS);
        f32x4* o = (f32x4*)(out + (size_t)m * DM) + lane;
#pragma unroll
        for (int j = 0; j < 4; ++j) o[64 * j] = v[j] * rstd * gv[j];
    }
}

using pg8::Unit;
DI void st_bf16x8(us* p, f32x4 a, f32x4 b) { u32x4 w; w.x = pk2(a[0], a[1]); w.y = pk2(a[2], a[3]); w.z = pk2(b[0], b[1]); w.w = pk2(b[2], b[3]); *(u32x4*)p = w; }
DI float sq8(f32x4 a, f32x4 b) { return (a[0] * a[0] + a[1] * a[1]) + (a[2] * a[2] + a[3] * a[3]) + (b[0] * b[0] + b[1] * b[1]) + (b[2] * b[2] + b[3] * b[3]); }

DI float rstd_x(const float* SSQX, int row) {
    const f32x4* p = (const f32x4*)(SSQX + (size_t)row * 32); f32x4 s = p[0];
#pragma unroll
    for (int j = 1; j < 8; ++j) s += p[j];
    return rsqrtf(((s[0] + s[1]) + (s[2] + s[3])) * (1.f / DM) + EPS);
}
DI void prep_rstd(const pg8::StaticOrder& S, const float* SSQX, float* RSTD) {
    int tid = threadIdx.x; asm volatile("" : "+v"(tid));
    Unit u;
    for (int i = 0; S.next(i, u); ++i) {
        const int row = u.pm * 256 + (tid >> 1);
        const f32x4* p = (const f32x4*)(SSQX + (size_t)row * 32 + (tid & 1) * 16);
        const f32x4 s = (p[0] + p[1]) + (p[2] + p[3]);
        float t = (s[0] + s[1]) + (s[2] + s[3]); t += __shfl_xor(t, 1);
        if ((tid & 1) == 0) RSTD[row] = rsqrtf(t * (1.f / DM) + EPS);
    }
    asm volatile("s_waitcnt vmcnt(0)" ::: "memory");
    __syncthreads();
}
struct EpiIn {
    static constexpr bool PERM = true, AFTER_DRAIN = false;
    unsigned char* ws;
    DI void operator()(const f32x4 (&acc)[2][2][4][2], const Unit& u, int wr, int wc, int fr, int fq) const {
        asm volatile("" : "+v"(fr), "+v"(fq));
        us* U = (us*)(ws + WS_U); us* V = (us*)(ws + WS_V); us* ZS = (us*)(ws + WS_ZS); us* XBC = (us*)(ws + WS_XBC); us* CQ = (us*)(ws + WS_CQ); us* CKV = (us*)(ws + WS_CKV); us* K = (us*)(ws + WS_K);
        float* SSQ = (float*)(ws + WS_SSQ); float* DT = (float*)(ws + WS_DT); const float* rope = (const float*)(ws + WS_ROPE);
        float rxa[2][4];
#pragma unroll
        for (int ai = 0; ai < 2; ++ai)
#pragma unroll
            for (int m = 0; m < 4; ++m) rxa[ai][m] = ((const float*)(ws + WS_RSTD))[u.pm * 256 + ai * 128 + wr * 64 + m * 16 + fr];
#pragma unroll
        for (int bj = 0; bj < 2; ++bj) {
            const int sg = 2 * u.pn + bj, c0 = 32 * wc + 8 * fq;
#pragma unroll
            for (int ai = 0; ai < 2; ++ai)
#pragma unroll
                for (int m = 0; m < 4; ++m) {
                    const int row = u.pm * 256 + ai * 128 + wr * 64 + m * 16 + fr;
                    const float rx = rxa[ai][m];
                    f32x4 v0 = acc[ai][bj][m][0] * rx, v1 = acc[ai][bj][m][1] * rx;
                    if (sg < 4) {
#pragma unroll
                        for (int e = 0; e < 4; ++e) { v0[e] = gelu_tanh(v0[e]); v1[e] = gelu_tanh(v1[e]); }
                        st_bf16x8((sg < 2 ? U : V) + (size_t)row * 256 + (sg & 1) * 128 + c0, v0, v1);
                        if (sg >= 2) { float s = sq8(v0, v1); s += __shfl_xor(s, 16); s += __shfl_xor(s, 32); if (fq == 0) SSQ[row * 32 + (sg - 2) * 4 + wc] = s; }
                    } else if (sg < 7) {
#pragma unroll
                        for (int e = 0; e < 4; ++e) { v0[e] = silu(v0[e]); v1[e] = silu(v1[e]); }
                        st_bf16x8(ZS + (size_t)row * 384 + (sg - 4) * 128 + c0, v0, v1);
                    } else if (sg < 12) {
                        st_bf16x8(XBC + (size_t)row * 640 + (sg - 7) * 128 + c0, v0, v1);
                    } else if (sg < 15) {
                        st_bf16x8(CQ + (size_t)row * 384 + (sg - 12) * 128 + c0, v0, v1);
                        float s = sq8(v0, v1); s += __shfl_xor(s, 16); s += __shfl_xor(s, 32); if (fq == 0) SSQ[row * 32 + 8 + (sg - 12) * 4 + wc] = s;
                    } else if (sg < 17) {
                        st_bf16x8(CKV + (size_t)row * 256 + (sg - 15) * 128 + c0, v0, v1);
                        float s = sq8(v0, v1); s += __shfl_xor(s, 16); s += __shfl_xor(s, 32); if (fq == 0) SSQ[row * 32 + 20 + (sg - 15) * 4 + wc] = s;
                    } else {
                        if (wc == 0) {
                            const f32x4 cs0 = *(const f32x4*)(rope + (size_t)row * 32 + 8 * fq), cs1 = *(const f32x4*)(rope + (size_t)row * 32 + 8 * fq + 4);
                            const float c[4] = {cs0[0], cs0[2], cs1[0], cs1[2]}, s[4] = {cs0[1], cs0[3], cs1[1], cs1[3]};
                            f32x4 o1, o2;
#pragma unroll
                            for (int e = 0; e < 4; ++e) { o1[e] = v0[e] * c[e] - v1[e] * s[e]; o2[e] = v1[e] * c[e] + v0[e] * s[e]; }
#pragma unroll
                            for (int hd = 0; hd < 6; ++hd) st_bf16x8(K + ((size_t)hd * M + row) * 96 + 64 + 8 * fq, o1, o2);
                        } else if (wc == 1 && fq == 0) { *(f32x4*)(DT + row * 8) = v0; *(f32x4*)(DT + row * 8 + 4) = v1; }
                    }
                }
        }
    }
};
struct EpiQ {
    static constexpr bool PERM = true, AFTER_DRAIN = false;
    us* Q; const float* SSQ; const float* rope;
    DI void operator()(const f32x4 (&acc)[2][2][4][2], const Unit& u, int wr, int wc, int fr, int fq) const {
        asm volatile("" : "+v"(fr), "+v"(fq));
#pragma unroll
        for (int ai = 0; ai < 2; ++ai)
#pragma unroll
            for (int m = 0; m < 4; ++m) {
                const int row = u.pm * 256 + ai * 128 + wr * 64 + m * 16 + fr;
                const f32x4 a = *(const f32x4*)(SSQ + row * 32 + 8), b = *(const f32x4*)(SSQ + row * 32 + 12), c = *(const f32x4*)(SSQ + row * 32 + 16);
                const float ss = ((a[0] + a[1]) + (a[2] + a[3])) + ((b[0] + b[1]) + (b[2] + b[3])) + ((c[0] + c[1]) + (c[2] + c[3]));
                const float sc = rsqrtf(ss * (1.f / 384.f) + EPS) * QSCALE;
#pragma unroll
                for (int bj = 0; bj < 2; ++bj) {
                    const int colb = u.pn * 256 + bj * 128 + 32 * wc;
                    if (colb >= 576) continue;
                    f32x4 v0 = acc[ai][bj][m][0] * sc, v1 = acc[ai][bj][m][1] * sc;
                    if ((colb >> 5) % 3 == 2) {
                        const f32x4 cs0 = *(const f32x4*)(rope + (size_t)row * 32 + 8 * fq), cs1 = *(const f32x4*)(rope + (size_t)row * 32 + 8 * fq + 4);
                        const float cc[4] = {cs0[0], cs0[2], cs1[0], cs1[2]}, sn[4] = {cs0[1], cs0[3], cs1[1], cs1[3]};
                        f32x4 o1, o2;
#pragma unroll
                        for (int e = 0; e < 4; ++e) { o1[e] = v0[e] * cc[e] - v1[e] * sn[e]; o2[e] = v1[e] * cc[e] + v0[e] * sn[e]; }
                        v0 = o1; v1 = o2;
                    }
                    st_bf16x8(Q + ((size_t)(colb / 96) * M + row) * 96 + (colb % 96) + 8 * fq, v0, v1);
                }
            }
    }
};
struct EpiKn {
    static constexpr bool PERM = true, AFTER_DRAIN = false;
    us* K; const float* SSQ;
    DI void operator()(const f32x4 (&acc)[2][2][4][2], const Unit& u, int wr, int wc, int fr, int fq) const {
        asm volatile("" : "+v"(fr), "+v"(fq));
#pragma unroll
        for (int ai = 0; ai < 2; ++ai)
#pragma unroll
            for (int m = 0; m < 4; ++m) {
                const int row = u.pm * 256 + ai * 128 + wr * 64 + m * 16 + fr;
                const f32x4 a = *(const f32x4*)(SSQ + row * 32 + 20), b = *(const f32x4*)(SSQ + row * 32 + 24);
                const float sc = rsqrtf((((a[0] + a[1]) + (a[2] + a[3])) + ((b[0] + b[1]) + (b[2] + b[3]))) * (1.f / 256.f) + EPS);
#pragma unroll
                for (int bj = 0; bj < 2; ++bj) {
                    const int col = u.pn * 256 + bj * 128 + 32 * wc + 8 * fq;
                    if (col >= 384) continue;
                    st_bf16x8(K + ((size_t)(col >> 6) * M + row) * 96 + (col & 63), acc[ai][bj][m][0] * sc, acc[ai][bj][m][1] * sc);
                }
            }
    }
};
struct EpiVt {
    static constexpr bool PERM = true, AFTER_DRAIN = false;
    us* VT; const float* SSQ;
    DI void operator()(const f32x4 (&acc)[2][2][4][2], const Unit& u, int wr, int wc, int fr, int fq) const {
        asm volatile("" : "+v"(fr), "+v"(fq));
#pragma unroll
        for (int bj = 0; bj < 2; ++bj) {
            const int tok0 = u.pn * 256 + bj * 128 + 32 * wc + 8 * fq;
            float rs[8];
#pragma unroll
            for (int e = 0; e < 8; ++e) { const f32x4 a = *(const f32x4*)(SSQ + (tok0 + e) * 32 + 20), b = *(const f32x4*)(SSQ + (tok0 + e) * 32 + 24);
                rs[e] = rsqrtf((((a[0] + a[1]) + (a[2] + a[3])) + ((b[0] + b[1]) + (b[2] + b[3]))) * (1.f / 256.f) + EPS); }
#pragma unroll
            for (int ai = 0; ai < 2; ++ai)
#pragma unroll
                for (int m = 0; m < 4; ++m) {
                    const int f = u.pm * 256 + ai * 128 + wr * 64 + m * 16 + fr;
                    if (f >= 384) continue;
                    f32x4 v0 = acc[ai][bj][m][0], v1 = acc[ai][bj][m][1];
#pragma unroll
                    for (int e = 0; e < 4; ++e) { v0[e] *= rs[e]; v1[e] *= rs[4 + e]; }
                    st_bf16x8(VT + (size_t)f * M + tok0, v0, v1);
                }
        }
    }
};
struct EpiRes {
    static constexpr bool PERM = true, AFTER_DRAIN = false;
    us* XB; float* SSQX;
    DI void operator()(const f32x4 (&acc)[2][2][4][2], const Unit& u, int wr, int wc, int fr, int fq) const {
        asm volatile("" : "+v"(fr), "+v"(fq));
#pragma unroll
        for (int ai = 0; ai < 2; ++ai)
#pragma unroll
            for (int m = 0; m < 4; ++m) {
                const int row = u.pm * 256 + ai * 128 + wr * 64 + m * 16 + fr;
#pragma unroll
                for (int bj = 0; bj < 2; ++bj) {
                    const size_t o = (size_t)row * DM + u.pn * 256 + bj * 128 + 32 * wc + 8 * fq;
                    const u32x4 xv = *(const u32x4*)(XB + o);
                    const f32x4 x0 = (f32x4){__uint_as_float(xv.x << 16), __uint_as_float(xv.x & 0xffff0000u), __uint_as_float(xv.y << 16), __uint_as_float(xv.y & 0xffff0000u)} + acc[ai][bj][m][0];
                    const f32x4 x1 = (f32x4){__uint_as_float(xv.z << 16), __uint_as_float(xv.z & 0xffff0000u), __uint_as_float(xv.w << 16), __uint_as_float(xv.w & 0xffff0000u)} + acc[ai][bj][m][1];
                    st_bf16x8(XB + o, x0, x1);
                    float s = sq8(x0, x1); s += __shfl_xor(s, 16); s += __shfl_xor(s, 32);
                    if (fq == 0) SSQX[row * 32 + u.pn * 8 + bj * 4 + wc] = s;
                }
            }
    }
};
struct EpiRelu2 {
    static constexpr bool PERM = true, AFTER_DRAIN = false;
    us* H; const float* RSTD;
    DI void operator()(const f32x4 (&acc)[2][2][4][2], const Unit& u, int wr, int wc, int fr, int fq) const {
        asm volatile("" : "+v"(fr), "+v"(fq));
        float rxa[2][4];
#pragma unroll
        for (int ai = 0; ai < 2; ++ai)
#pragma unroll
            for (int m = 0; m < 4; ++m) rxa[ai][m] = RSTD[u.pm * 256 + ai * 128 + wr * 64 + m * 16 + fr];
#pragma unroll
        for (int ai = 0; ai < 2; ++ai)
#pragma unroll
            for (int m = 0; m < 4; ++m) {
                const int row = u.pm * 256 + ai * 128 + wr * 64 + m * 16 + fr;
                const float rx = rxa[ai][m];
#pragma unroll
                for (int bj = 0; bj < 2; ++bj) {
                    f32x4 v0 = acc[ai][bj][m][0], v1 = acc[ai][bj][m][1];
#pragma unroll
                    for (int e = 0; e < 4; ++e) { const float a = fmaxf(v0[e], 0.f) * rx, b = fmaxf(v1[e], 0.f) * rx; v0[e] = a * a; v1[e] = b * b; }
                    st_bf16x8(H + (size_t)row * FF + u.pn * 256 + bj * 128 + 32 * wc + 8 * fq, v0, v1);
                }
            }
    }
};
DI void ld16bf(const us* p, float* o) {
    const u32x4 a = *(const u32x4*)p, b = *(const u32x4*)(p + 8);
    const unsigned w[8] = {a.x, a.y, a.z, a.w, b.x, b.y, b.z, b.w};
#pragma unroll
    for (int j = 0; j < 8; ++j) { o[2 * j] = __uint_as_float(w[j] << 16); o[2 * j + 1] = __uint_as_float(w[j] & 0xffff0000u); }
}
DI void conv16(const us* XBC, int row, int col, const float* cw, const float* cb, float* o) {
#pragma unroll
    for (int j = 0; j < 16; ++j) o[j] = cb[col + j];
#pragma unroll
    for (int k = 0; k < 4; ++k) {
        const int r = row - 3 + k;
        if (r >= 0) { float x[16]; ld16bf(XBC + (size_t)r * 640 + col, x);
#pragma unroll
            for (int j = 0; j < 16; ++j) o[j] += cw[k * 640 + col + j] * x[j]; }
    }
#pragma unroll
    for (int j = 0; j < 16; ++j) o[j] = silu(o[j]);
}
DI void st16bf(us* p, const float* o) {
    u32x4 a, b; a.x = pk2(o[0], o[1]); a.y = pk2(o[2], o[3]); a.z = pk2(o[4], o[5]); a.w = pk2(o[6], o[7]); b.x = pk2(o[8], o[9]); b.y = pk2(o[10], o[11]); b.z = pk2(o[12], o[13]); b.w = pk2(o[14], o[15]);
    *(u32x4*)p = a; *(u32x4*)(p + 8) = b;
}

struct ConvIn { u32x2 v[7]; f32x4 w[4]; f32x4 b; };
DI void conv4x4_load(ConvIn& ci, const us* XBC, int row0, int col, const float* cw, const float* cb) {
#pragma unroll
    for (int r7 = 0; r7 < 7; ++r7) { const int rr = row0 - 3 + r7; ci.v[r7] = (u32x2){0u, 0u}; if (rr >= 0) ci.v[r7] = *(const u32x2*)(XBC + (size_t)rr * 640 + col); }
#pragma unroll
    for (int k = 0; k < 4; ++k) ci.w[k] = *(const f32x4*)(cw + k * 640 + col);
    ci.b = *(const f32x4*)(cb + col);
}
DI void conv4x4_compute(const ConvIn& ci, float (&o)[4][4]) {
    float x[7][4];
#pragma unroll
    for (int r7 = 0; r7 < 7; ++r7) { const u32x2 v = ci.v[r7];
        x[r7][0] = __uint_as_float(v.x << 16); x[r7][1] = __uint_as_float(v.x & 0xffff0000u); x[r7][2] = __uint_as_float(v.y << 16); x[r7][3] = __uint_as_float(v.y & 0xffff0000u); }
#pragma unroll
    for (int tt = 0; tt < 4; ++tt)
#pragma unroll
        for (int j = 0; j < 4; ++j) o[tt][j] = silu(ci.b[j] + (ci.w[0][j] * x[tt][j] + ci.w[1][j] * x[tt + 1][j]) + (ci.w[2][j] * x[tt + 2][j] + ci.w[3][j] * x[tt + 3][j]));
}
DI void conv4x4(const us* XBC, int row0, int col, const float* cw, const float* cb, float (&o)[4][4]) { ConvIn ci; conv4x4_load(ci, XBC, row0, col, cw, cb); conv4x4_compute(ci, o); }
DI u32x2 pk4(float a, float b, float c, float d) { u32x2 r; r.x = pk2(a, b); r.y = pk2(c, d); return r; }
DI void ssd_item(unsigned char* smem, int c, int g, const us* XBC, const float* DT, const float* cw, const float* cb, const float* dt_bias, const float* a_log, const float* d_skip,
                 us* Y, float* ST, float* ACUM, float* DEC, us* CC) {
    us* Cs = (us*)smem; us* Bs = (us*)(smem + 18432); us* BT = (us*)(smem + 36864); us* XT = (us*)(smem + 54272); us* XS = (us*)(smem + 71680); us* Wm = (us*)(smem + 89088);
    float* av = (float*)(smem + 123904); float* dtv = (float*)(smem + 125440);
    int tid_l = threadIdx.x; asm volatile("" : "+v"(tid_l));
    const int tid = tid_l, wave = tid >> 6, lane = tid & 63, hf = lane >> 5;
    const int t0 = (tid >> 4) * 4, cc = (tid & 15) * 4, row0 = c * 128 + t0;
    if (wave < 3) {
        const int h = 3 * g + wave; const float A = -__expf(a_log[h]), bias = dt_bias[h];
        const int s0 = 2 * lane, s1 = s0 + 1;
        const float dt0 = softplus(DT[(c * 128 + s0) * 8 + h] + bias), dt1 = softplus(DT[(c * 128 + s1) * 8 + h] + bias);
        const float x0 = dt0 * A, x1 = x0 + dt1 * A;
        float incl = x1;
#pragma unroll
        for (int o = 1; o < 64; o <<= 1) { const float y = __shfl_up(incl, o); if (lane >= o) incl += y; }
        const float excl = incl - x1;
        av[wave * 128 + s0] = excl + x0; av[wave * 128 + s1] = excl + x1; dtv[wave * 128 + s0] = dt0; dtv[wave * 128 + s1] = dt1;
        ACUM[(c * 128 + s0) * 8 + h] = excl + x0; ACUM[(c * 128 + s1) * 8 + h] = excl + x1;
        if (lane == 63) DEC[c * 8 + h] = __expf(incl);
    }
    {
        float o[4][4];
        conv4x4(XBC, row0, 384 + 64 * g + cc, cw, cb, o);
#pragma unroll
        for (int tt = 0; tt < 4; ++tt) *(u32x2*)(Bs + (t0 + tt) * 72 + cc) = pk4(o[tt][0], o[tt][1], o[tt][2], o[tt][3]);
#pragma unroll
        for (int j = 0; j < 4; ++j) *(u32x2*)(BT + (cc + j) * 136 + t0) = pk4(o[0][j], o[1][j], o[2][j], o[3][j]);
        conv4x4(XBC, row0, 512 + 64 * g + cc, cw, cb, o);
#pragma unroll
        for (int tt = 0; tt < 4; ++tt) { const u32x2 v = pk4(o[tt][0], o[tt][1], o[tt][2], o[tt][3]); *(u32x2*)(Cs + (t0 + tt) * 72 + cc) = v; *(u32x2*)(CC + (size_t)(row0 + tt) * 128 + 64 * g + cc) = v; }
    }
    __syncthreads();
    const int tb = wave >> 1, sb0 = 2 * (wave & 1);
    f32x16 cbm[2];
#pragma unroll
    for (int i = 0; i < 16; ++i) { cbm[0][i] = 0.f; cbm[1][i] = 0.f; }
    mm32(cbm[0], Cs + tb * 32 * 72, 72, Bs + sb0 * 32 * 72, 72, 4, lane);
    mm32(cbm[1], Cs + tb * 32 * 72, 72, Bs + (sb0 + 1) * 32 * 72, 72, 4, lane);
#pragma unroll 1
    for (int hh = 0; hh < 3; ++hh) {
        const int h = 3 * g + hh;
        {
            float o[4][4];
            conv4x4(XBC, row0, 64 * h + cc, cw, cb, o);
            float dte[4];
#pragma unroll
            for (int tt = 0; tt < 4; ++tt) dte[tt] = __expf(av[hh * 128 + 127] - av[hh * 128 + t0 + tt]) * dtv[hh * 128 + t0 + tt];
#pragma unroll
            for (int j = 0; j < 4; ++j) { *(u32x2*)(XT + (cc + j) * 136 + t0) = pk4(o[0][j], o[1][j], o[2][j], o[3][j]);
                *(u32x2*)(XS + (cc + j) * 136 + t0) = pk4(o[0][j] * dte[0], o[1][j] * dte[1], o[2][j] * dte[2], o[3][j] * dte[3]); }
        }
#pragma unroll
        for (int blk = 0; blk < 2; ++blk) {
            const int s = (sb0 + blk) * 32 + (lane & 31); const float as = av[hh * 128 + s], dts = dtv[hh * 128 + s];
#pragma unroll
            for (int i = 0; i < 16; ++i) { const int t_ = tb * 32 + crow(i, hf);
                float w = cbm[blk][i] * __builtin_amdgcn_exp2f(fminf(av[hh * 128 + t_] - as, 0.f) * 1.4426950408889634f) * dts;
                w = (s <= t_) ? w : 0.f;
                Wm[t_ * 136 + s] = f2bf(w); }
        }
        __syncthreads();
        {
            const int pb = wave & 1; f32x16 acc;
#pragma unroll
            for (int i = 0; i < 16; ++i) acc[i] = 0.f;
            mm32(acc, Wm + tb * 32 * 136, 136, XT + pb * 32 * 136, 136, 8, lane);
            const int p = pb * 32 + (lane & 31); const float dsk = d_skip[h];
#pragma unroll
            for (int i = 0; i < 16; ++i) { const int t_ = tb * 32 + crow(i, hf); Y[(size_t)(c * 128 + t_) * 384 + h * 64 + p] = f2bf(acc[i] + bf2f(XT[p * 136 + t_]) * dsk); }
        }
        if (wave < 4) {
            const int pb = wave >> 1, nb = wave & 1; f32x16 acc;
#pragma unroll
            for (int i = 0; i < 16; ++i) acc[i] = 0.f;
            mm32(acc, XS + pb * 32 * 136, 136, BT + nb * 32 * 136, 136, 8, lane);
            const int n = nb * 32 + (lane & 31);
#pragma unroll
            for (int i = 0; i < 16; ++i) { const int p_ = pb * 32 + crow(i, hf); ST[((size_t)(c * 6 + h) * 64 + p_) * 64 + n] = acc[i]; }
        }
        __syncthreads();
    }
}

DI void gmlp_item(unsigned char* smem, int c, int h, const us* U, const us* V, const float* SSQ, const float* gv, const float* w_s, const float* b_s, us* mix) {
    us* Ws = (us*)smem; us* VTs = (us*)(smem + 34816);
    int tid_l = threadIdx.x; asm volatile("" : "+v"(tid_l));
    const int tid = tid_l, wave = tid >> 6, lane = tid & 63, hf = lane >> 5;
    const int t = tid >> 2, cq = (tid & 3) * 16, row = c * 128 + t;
    {
        const f32x4 a = *(const f32x4*)(SSQ + row * 32), b = *(const f32x4*)(SSQ + row * 32 + 4);
        const float rstd = rsqrtf((((a[0] + a[1]) + (a[2] + a[3])) + ((b[0] + b[1]) + (b[2] + b[3]))) * (1.f / 256.f) + EPS);
        float x[16]; ld16bf(V + (size_t)row * 256 + 64 * h + cq, x);
#pragma unroll
        for (int j = 0; j < 16; ++j) VTs[(cq + j) * 136 + t] = f2bf(x[j] * rstd * gv[64 * h + cq + j]);
        const int s0 = (tid & 3) * 32; const float* wr = w_s + ((size_t)h * 128 + t) * 128 + s0;
#pragma unroll
        for (int q = 0; q < 4; ++q) {
            const f32x4 w0 = *(const f32x4*)(wr + 8 * q), w1 = *(const f32x4*)(wr + 8 * q + 4); f32x4 m0, m1;
#pragma unroll
            for (int e = 0; e < 4; ++e) { m0[e] = (s0 + 8 * q + e <= t) ? w0[e] : 0.f; m1[e] = (s0 + 8 * q + 4 + e <= t) ? w1[e] : 0.f; }
            st_bf16x8(Ws + t * 136 + s0 + 8 * q, m0, m1);
        }
    }
    const int tb = wave >> 1, db = wave & 1, d = db * 32 + (lane & 31);
    float uv[16], bv[16];
#pragma unroll
    for (int i = 0; i < 16; ++i) { const int t_ = tb * 32 + crow(i, hf); uv[i] = bf2f(U[((size_t)c * 128 + t_) * 256 + 64 * h + d]); bv[i] = b_s[h * 128 + t_]; }
    __syncthreads();
    {
        f32x16 acc;
#pragma unroll
        for (int i = 0; i < 16; ++i) acc[i] = 0.f;
        mm32(acc, Ws + tb * 32 * 136, 136, VTs + db * 32 * 136, 136, 8, lane);
#pragma unroll
        for (int i = 0; i < 16; ++i) { const int t_ = tb * 32 + crow(i, hf); const size_t r_ = (size_t)c * 128 + t_;
            mix[r_ * DM + 64 * h + d] = f2bf((acc[i] + bv[i]) * uv[i]); }
    }
    __syncthreads();
}

DI void ssd_final_item(unsigned char* smem, int c, int g, const us* CC, const float* ST, const us* Y, const float* ACUM, const us* ZS, const float* ng, us* mix) {
    us* Cs = (us*)smem; us* HP = (us*)(smem + 18432); float* YG = (float*)(smem + 27648);
    int tid_l = threadIdx.x; asm volatile("" : "+v"(tid_l));
    const int tid = tid_l, wave = tid >> 6, lane = tid & 63, hf = lane >> 5;
    const int t = tid >> 2, cq = (tid & 3) * 16;
    const int hp_p = tid >> 3, hp_n0 = (tid & 7) * 8;
    const int tb = wave >> 1, pb = wave & 1, p = pb * 32 + (lane & 31);
    f32x4 h0, h1;
    { const float* src = ST + ((size_t)(c * 6 + 3 * g) * 64 + hp_p) * 64 + hp_n0; h0 = *(const f32x4*)src; h1 = *(const f32x4*)(src + 4); }
    { const us* src = CC + (size_t)(c * 128 + t) * 128 + 64 * g + cq; *(u32x4*)(Cs + t * 72 + cq) = *(const u32x4*)src; *(u32x4*)(Cs + t * 72 + cq + 8) = *(const u32x4*)(src + 8); }
#pragma unroll 1
    for (int hh = 0; hh < 3; ++hh) {
        const int h = 3 * g + hh;
        st_bf16x8(HP + hp_p * 72 + hp_n0, h0, h1);
        if (hh < 2) { const float* src = ST + ((size_t)(c * 6 + h + 1) * 64 + hp_p) * 64 + hp_n0; h0 = *(const f32x4*)src; h1 = *(const f32x4*)(src + 4); }
        float yv[16], av[16], zv[16];
#pragma unroll
        for (int i = 0; i < 16; ++i) { const size_t r_ = (size_t)c * 128 + tb * 32 + crow(i, hf);
            yv[i] = bf2f(Y[r_ * 384 + h * 64 + p]); av[i] = ACUM[r_ * 8 + h]; zv[i] = bf2f(ZS[r_ * 384 + h * 64 + p]); }
        __syncthreads();
        {
            f32x16 acc;
#pragma unroll
            for (int i = 0; i < 16; ++i) acc[i] = 0.f;
            mm32(acc, Cs + tb * 32 * 72, 72, HP + pb * 32 * 72, 72, 4, lane);
#pragma unroll
            for (int i = 0; i < 16; ++i) { const int t_ = tb * 32 + crow(i, hf);
                YG[t_ * 196 + hh * 64 + p] = (yv[i] + __expf(av[i]) * acc[i]) * zv[i]; }
        }
        __syncthreads();
    }
    {
        const int part = tid & 3; const float* yr = YG + t * 196 + part * 48; float v[48]; float ss = 0.f;
#pragma unroll
        for (int q = 0; q < 12; ++q) { const f32x4 a = *(const f32x4*)(yr + 4 * q); v[4 * q] = a[0]; v[4 * q + 1] = a[1]; v[4 * q + 2] = a[2]; v[4 * q + 3] = a[3]; ss += (a[0] * a[0] + a[1] * a[1]) + (a[2] * a[2] + a[3] * a[3]); }
        ss += __shfl_xor(ss, 1); ss += __shfl_xor(ss, 2);
        const float rstd = rsqrtf(ss * (1.f / 192.f) + EPS);
        const float* gp = ng + 192 * g + part * 48; us* dst = mix + (size_t)(c * 128 + t) * DM + 256 + 192 * g + part * 48;
#pragma unroll
        for (int q = 0; q < 6; ++q) { f32x4 a, b;
#pragma unroll
            for (int e = 0; e < 4; ++e) { a[e] = v[8 * q + e] * rstd * gp[8 * q + e]; b[e] = v[8 * q + 4 + e] * rstd * gp[8 * q + 4 + e]; }
            st_bf16x8(dst + 8 * q, a, b); }
    }
    __syncthreads();
}

constexpr int ATT_NQB = 64, ATT_ITEMS = 960;
DI int att_slot(int h, int qb, int kc) { const int g = qb >> 4, b = qb & 15; const int base = (g == 1) ? 2 * b : (g == 2) ? 32 + 3 * b : 80 + 4 * b; return h * 144 + base + kc; }
DI size_t att_slot_off(int slot) { return (size_t)slot * 16384; }
DI void att_decode(int u, int& h, int& qb, int& kc) {
    if (u < 576) { h = u % 6; const int v = u / 6;
        if (v < 16) { qb = 16 + v; kc = 0; } else if (v < 48) { const int w = v - 16; qb = 32 + (w >> 1); kc = w & 1; } else { const int w = v - 48; qb = 48 + w / 3; kc = w % 3; }
    } else { const int d = u - 576; h = d % 6; const int e = d / 6, q = e & 3; qb = 16 * q + 15 - (e >> 2); kc = q; }
}
constexpr int AT_KB = 64 * 208, AT_VB = 64 * 144;
DI void attn_unit(unsigned char* smem, const us* Q, const us* K, const us* VT, us* mix, us* PO, float* PML, int h, int qb, int kc) {
    int tid_l = threadIdx.x; asm volatile("" : "+v"(tid_l));
    const int tid = tid_l, wave = tid >> 6, lane = tid & 63, r = lane & 31, hf = lane >> 5;
    const int q0 = qb * 256 + wave * 32, qrow = q0 + r;
    bf16x8 qf[6];
#pragma unroll
    for (int ks = 0; ks < 6; ++ks) qf[ks] = *(const bf16x8*)(Q + ((size_t)h * M + qrow) * 96 + 16 * ks + 8 * hf);
    f32x16 o0, o1;
#pragma unroll
    for (int i = 0; i < 16; ++i) { o0[i] = 0.f; o1[i] = 0.f; }
    float mrun = -1e30f, lrun = 0.f;
    const int t0 = 64 * kc, tend = (64 * (kc + 1) < 4 * (qb + 1)) ? 64 * (kc + 1) : 4 * (qb + 1), ntiles = tend - t0, tg = __builtin_amdgcn_readfirstlane(q0 >> 6);
    const bool masked = tg < tend; const int tlw = (masked ? tg : tend - 1) - t0;
    const int id1 = 512 + (tid & 255);
    const int kg0 = tid * 8, kl0 = (tid / 12) * 104 + (tid % 12) * 8, kg1 = id1 * 8, kl1 = (id1 / 12) * 104 + (id1 % 12) * 8;
    const int vl0 = (tid >> 3) * 72 + ((tid & 7) >> 1) * 16 + (tid & 1) * 4;
    const us* Kg = K + (size_t)h * M * 96; const us* Vg = VT + (size_t)(h * 64 + (tid >> 3)) * M + (tid & 7) * 8;
    us* Kb0 = (us*)smem; us* Kb1 = (us*)(smem + AT_KB); us* Vb0 = (us*)(smem + 2 * AT_KB); us* Vb1 = (us*)(smem + 2 * AT_KB + AT_VB);
    u32x4 ka0, ka1, va, kb0, kb1, vb;
#define AT_LDK(R0, R1, t) do { const size_t kn_ = (size_t)(t0 + ((t) < ntiles ? (t) : ntiles - 1)) * 64; R0 = *(const u32x4*)(Kg + kn_ * 96 + kg0); R1 = *(const u32x4*)(Kg + kn_ * 96 + kg1); } while (0)
#define AT_LDV(R, t) do { const size_t kn_ = (size_t)(t0 + ((t) < ntiles ? (t) : ntiles - 1)) * 64; R = *(const u32x4*)(Vg + kn_); } while (0)
#define AT_STK(R0, R1, Kb) do { *(u32x4*)((Kb) + kl0) = R0; *(u32x4*)((Kb) + kl1) = R1; } while (0)
#define AT_STV(R, Vb) do { *(u32x2*)((Vb) + vl0) = (u32x2){R.x, R.y}; *(u32x2*)((Vb) + vl0 + 8) = (u32x2){R.z, R.w}; } while (0)
#define AT_QK(S0, S1, Kb) do { \
        _Pragma("unroll") for (int i = 0; i < 16; ++i) { S0[i] = 0.f; S1[i] = 0.f; } \
        _Pragma("unroll") for (int ks = 0; ks < 6; ++ks) { \
            const bf16x8 a0 = *(const bf16x8*)((Kb) + r * 104 + 16 * ks + 8 * hf), a1 = *(const bf16x8*)((Kb) + (32 + r) * 104 + 16 * ks + 8 * hf); \
            S0 = MFMA32(a0, qf[ks], S0); S1 = MFMA32(a1, qf[ks], S1); } } while (0)
#define AT_MASK(S0, S1, kbase) do { \
        _Pragma("unroll") for (int i = 0; i < 16; ++i) { const int key = (kbase) + crow(i, hf); if (key > qrow) S0[i] = -1e30f; if (key + 32 > qrow) S1[i] = -1e30f; } } while (0)
#define AT_SMPV(S0, S1, Vb) do { \
        float mx = fmaxf(S0[0], S1[0]); \
        _Pragma("unroll") for (int i = 1; i < 16; ++i) mx = fmaxf(mx, fmaxf(S0[i], S1[i])); \
        mx = fmaxf(mx, __shfl_xor(mx, 32)); \
        const float mnew = fmaxf(mrun, mx), alpha = __builtin_amdgcn_exp2f(mrun - mnew); \
        float rs = 0.f; \
        _Pragma("unroll") for (int i = 0; i < 16; ++i) { S0[i] = __builtin_amdgcn_exp2f(S0[i] - mnew); S1[i] = __builtin_amdgcn_exp2f(S1[i] - mnew); rs += S0[i] + S1[i]; } \
        rs += __shfl_xor(rs, 32); \
        lrun = lrun * alpha + rs; mrun = mnew; \
        if (__builtin_amdgcn_ballot_w64(alpha != 1.0f)) { _Pragma("unroll") for (int i = 0; i < 16; ++i) { o0[i] *= alpha; o1[i] *= alpha; } } \
        _Pragma("unroll") for (int j4 = 0; j4 < 4; ++j4) { \
            const int kb = j4 >> 1, s_ = j4 & 1; u32x4 pw; \
            if (kb == 0) { pw.x = pk2(S0[8 * s_], S0[8 * s_ + 1]); pw.y = pk2(S0[8 * s_ + 2], S0[8 * s_ + 3]); pw.z = pk2(S0[8 * s_ + 4], S0[8 * s_ + 5]); pw.w = pk2(S0[8 * s_ + 6], S0[8 * s_ + 7]); } \
            else         { pw.x = pk2(S1[8 * s_], S1[8 * s_ + 1]); pw.y = pk2(S1[8 * s_ + 2], S1[8 * s_ + 3]); pw.z = pk2(S1[8 * s_ + 4], S1[8 * s_ + 5]); pw.w = pk2(S1[8 * s_ + 6], S1[8 * s_ + 7]); } \
            const bf16x8 pf = __builtin_bit_cast(bf16x8, pw); \
            const int koff = kb * 32 + 16 * s_ + 8 * hf; \
            const bf16x8 a0 = *(const bf16x8*)((Vb) + r * 72 + koff), a1 = *(const bf16x8*)((Vb) + (32 + r) * 72 + koff); \
            o0 = MFMA32(a0, pf, o0); o1 = MFMA32(a1, pf, o1); } } while (0)
    AT_LDK(ka0, ka1, 0); AT_LDV(va, 0); AT_STK(ka0, ka1, Kb0); AT_STV(va, Vb0);
    AT_LDK(ka0, ka1, 1); AT_STK(ka0, ka1, Kb1);
    AT_LDK(kb0, kb1, 2); AT_LDV(vb, 1);
    __syncthreads();
    f32x16 sa0, sa1, sb0, sb1;
    AT_QK(sa0, sa1, Kb0);
    __syncthreads();
    int t = 0;
#define AT_EVEN_TAIL() do { AT_STK(kb0, kb1, Kb0); AT_STV(vb, Vb1); __syncthreads(); } while (0)
#define AT_ODD_TAIL() do { AT_STK(ka0, ka1, Kb1); AT_STV(va, Vb0); __syncthreads(); } while (0)
#pragma unroll 1
    for (; t + 1 < tlw; t += 2) {
        AT_LDK(ka0, ka1, t + 3); AT_LDV(va, t + 2);
        AT_QK(sb0, sb1, Kb1);
        AT_SMPV(sa0, sa1, Vb0);
        AT_EVEN_TAIL();
        AT_LDK(kb0, kb1, t + 4); AT_LDV(vb, t + 3);
        AT_QK(sa0, sa1, Kb0);
        AT_SMPV(sb0, sb1, Vb1);
        AT_ODD_TAIL();
    }
    if (t < tlw) {
        AT_LDK(ka0, ka1, t + 3); AT_LDV(va, t + 2);
        AT_QK(sb0, sb1, Kb1);
        AT_SMPV(sa0, sa1, Vb0);
        AT_EVEN_TAIL();
        ++t;
        AT_LDK(kb0, kb1, t + 3); AT_LDV(vb, t + 2);
        if (masked) AT_MASK(sb0, sb1, (t0 + t) * 64);
        AT_SMPV(sb0, sb1, Vb1);
        AT_ODD_TAIL();
        ++t;
    } else {
        AT_LDK(ka0, ka1, t + 3); AT_LDV(va, t + 2);
        if (masked) AT_MASK(sa0, sa1, (t0 + t) * 64);
        AT_SMPV(sa0, sa1, Vb0);
        AT_EVEN_TAIL();
        ++t;
    }
#pragma unroll 1
    for (; t < ntiles; ++t) {
        if (t & 1) { AT_LDK(kb0, kb1, t + 3); AT_LDV(vb, t + 2); AT_ODD_TAIL(); } else { AT_LDK(ka0, ka1, t + 3); AT_LDV(va, t + 2); AT_EVEN_TAIL(); }
    }
#undef AT_EVEN_TAIL
#undef AT_ODD_TAIL
#undef AT_LDK
#undef AT_LDV
#undef AT_STK
#undef AT_STV
#undef AT_QK
#undef AT_MASK
#undef AT_SMPV
    if (qb < 16) {
        const float inv = 1.f / lrun;
        us* dst = mix + (size_t)qrow * DM + 640 + h * 64;
#pragma unroll
        for (int gq = 0; gq < 4; ++gq) {
            u32x2 w0, w1;
            w0.x = pk2(o0[4 * gq] * inv, o0[4 * gq + 1] * inv); w0.y = pk2(o0[4 * gq + 2] * inv, o0[4 * gq + 3] * inv);
            w1.x = pk2(o1[4 * gq] * inv, o1[4 * gq + 1] * inv); w1.y = pk2(o1[4 * gq + 2] * inv, o1[4 * gq + 3] * inv);
            *(u32x2*)(dst + 8 * gq + 4 * hf) = w0; *(u32x2*)(dst + 32 + 8 * gq + 4 * hf) = w1;
        }
    } else {
        const int slot = att_slot(h, qb, kc), rowl = wave * 32 + r;
        us* po = PO + att_slot_off(slot) + (size_t)rowl * 64;
#pragma unroll
        for (int gq = 0; gq < 4; ++gq) {
            u32x2 w0, w1;
            w0.x = pk2(o0[4 * gq], o0[4 * gq + 1]); w0.y = pk2(o0[4 * gq + 2], o0[4 * gq + 3]);
            w1.x = pk2(o1[4 * gq], o1[4 * gq + 1]); w1.y = pk2(o1[4 * gq + 2], o1[4 * gq + 3]);
            *(u32x2*)(po + 8 * gq + 4 * hf) = w0; *(u32x2*)(po + 32 + 8 * gq + 4 * hf) = w1;
        }
        if (hf == 0) { PML[((size_t)slot * 256 + rowl) * 2] = mrun; PML[((size_t)slot * 256 + rowl) * 2 + 1] = lrun; }
    }
}
DI void attn_merge(const us* PO, const float* PML, us* mix, int h, int qb) {
    int tid = threadIdx.x; asm volatile("" : "+v"(tid));
    const int row = tid >> 1, c0 = (tid & 1) * 32, nch = (qb >> 4) + 1;
    float mk[4], lk[4], M_ = -1e30f;
#pragma unroll
    for (int k = 0; k < 4; ++k) if (k < nch) { const size_t ix = ((size_t)att_slot(h, qb, k) * 256 + row) * 2; mk[k] = PML[ix]; lk[k] = PML[ix + 1]; M_ = fmaxf(M_, mk[k]); }
    float L = 0.f, wk[4];
#pragma unroll
    for (int k = 0; k < 4; ++k) if (k < nch) { wk[k] = __builtin_amdgcn_exp2f(mk[k] - M_); L += wk[k] * lk[k]; }
    const float inv = 1.f / L;
    f32x4 acc[8];
#pragma unroll
    for (int j = 0; j < 8; ++j) acc[j] = (f32x4){0.f, 0.f, 0.f, 0.f};
#pragma unroll
    for (int k = 0; k < 4; ++k) if (k < nch) { const us* po = PO + att_slot_off(att_slot(h, qb, k)) + (size_t)row * 64 + c0; const float w = wk[k] * inv;
#pragma unroll
        for (int j = 0; j < 4; ++j) { const u32x4 v = *(const u32x4*)(po + 8 * j);
            acc[2 * j] += (f32x4){__uint_as_float(v.x << 16), __uint_as_float(v.x & 0xffff0000u), __uint_as_float(v.y << 16), __uint_as_float(v.y & 0xffff0000u)} * w;
            acc[2 * j + 1] += (f32x4){__uint_as_float(v.z << 16), __uint_as_float(v.z & 0xffff0000u), __uint_as_float(v.w << 16), __uint_as_float(v.w & 0xffff0000u)} * w; } }
    us* dst = mix + (size_t)(qb * 256 + row) * DM + 640 + h * 64 + c0;
#pragma unroll
    for (int j = 0; j < 4; ++j) st_bf16x8(dst + 8 * j, acc[2 * j], acc[2 * j + 1]);
}
DI const void* ldp_g(const unsigned char* lds, int i, const unsigned char* gbase) {
    const volatile unsigned* t = (const volatile unsigned*)(lds + 131328) + 2 * i;
    const unsigned lo = __builtin_amdgcn_readfirstlane(t[0]), hi = __builtin_amdgcn_readfirstlane(t[1]);
    const long long off = (long long)((((unsigned long long)hi << 32) | lo) - (unsigned long long)gbase);
    return (const void*)(gbase + off);
}
#define LAS __attribute__((address_space(3)))
#define XB_TMO      128
#define XB_XCNT(j)  (256  + 64 * (j))
#define XB_XSUB(j)  (1280 + 64 * (j))
#define XB_XGEN(j)  (2304 + 64 * (j))
#define XB_TOP      3328
#define XB_TOPGEN   3392
#define XCD_BAR_WORDS 3456
#define XB_SPIN_CAP (1u << 18)

__device__ __forceinline__ unsigned xb_ld(unsigned* p)              { return __hip_atomic_load(p, __ATOMIC_RELAXED, __HIP_MEMORY_SCOPE_AGENT); }
__device__ __forceinline__ unsigned xb_add(unsigned* p, unsigned v) { return __hip_atomic_fetch_add(p, v, __ATOMIC_RELAXED, __HIP_MEMORY_SCOPE_AGENT); }
__device__ __forceinline__ unsigned xb_xcc_id() { return (unsigned)__builtin_amdgcn_s_getreg((3 << 11) | 20) & 0xFu; }
#define XB_SPIN(cond, bar) do { unsigned _sp = 0; while (cond) { __builtin_amdgcn_s_sleep(1); \
    if ((++_sp & 255u) == 0u) { if (xb_ld(&(bar)[XB_TMO])) break; if (_sp > XB_SPIN_CAP) { atomicAdd(&(bar)[XB_TMO], 1u); break; } } } } while (0)

struct XcdBarrier {
    unsigned* bar; unsigned x;
    volatile LAS unsigned* st;
};

__device__ __forceinline__ XcdBarrier xcd_barrier_post(unsigned* bar, volatile LAS unsigned* st) {
    XcdBarrier b; b.bar = bar; b.x = xb_xcc_id(); b.st = st;
    if (threadIdx.x == 0) (void)xb_add(&bar[XB_XCNT(b.x)], 1u);
    return b;
}
__device__ __forceinline__ void xcd_barrier_complete(unsigned* bar, unsigned x, unsigned& nloc, unsigned& nx) {
    const unsigned G = gridDim.x * gridDim.y * gridDim.z;
    unsigned sum, cnt, mine, sp = 0u;
    for (;;) {
        sum = 0u; cnt = 0u; mine = 0u;
#pragma unroll
        for (unsigned j = 0; j < 16; ++j) { const unsigned c = xb_ld(&bar[XB_XCNT(j)]); sum += c; cnt += (c > 0u) ? 1u : 0u; mine = (j == x) ? c : mine; }
        if (sum == G) break;
        __builtin_amdgcn_s_sleep(1);
        if ((++sp & 255u) == 0u) { if (xb_ld(&bar[XB_TMO])) break; if (sp > XB_SPIN_CAP) { atomicAdd(&bar[XB_TMO], 1u); break; } }
    }
    nloc = mine > 0u ? mine : 1u; nx = cnt > 0u ? cnt : 1u;
}

__device__ __forceinline__ void xcd_barrier(const XcdBarrier& b) {
    asm volatile("s_waitcnt vmcnt(0)" ::: "memory");
    __syncthreads();
    if (threadIdx.x == 0) {
        unsigned* bar = b.bar;
        __builtin_amdgcn_s_waitcnt(0);
        unsigned nloc = b.st[0], nx = b.st[1];
        if (nloc == 0u) { xcd_barrier_complete(bar, b.x, nloc, nx); b.st[0] = nloc; b.st[1] = nx; }
        const unsigned old = xb_add(&bar[XB_XSUB(b.x)], 1u);
        const unsigned gen = old / nloc;
        if (old + 1u == (gen + 1u) * nloc) {
            __builtin_amdgcn_fence(__ATOMIC_RELEASE, "agent");
            asm volatile("s_waitcnt vmcnt(0)" ::: "memory");
            const unsigned og = xb_add(&bar[XB_TOP], 1u);
            const unsigned tg = og / nx;
            if (og + 1u == (tg + 1u) * nx) xb_add(&bar[XB_TOPGEN], 1u);
            else XB_SPIN(xb_ld(&bar[XB_TOPGEN]) == tg, bar);
            __builtin_amdgcn_fence(__ATOMIC_ACQUIRE, "agent");
            xb_add(&bar[XB_XGEN(b.x)], 1u);
            asm volatile("s_waitcnt vmcnt(0)" ::: "memory");
        } else {
            XB_SPIN(xb_ld(&bar[XB_XGEN(b.x)]) == gen, bar);
            __builtin_amdgcn_fence(__ATOMIC_ACQUIRE, "agent");
            asm volatile("s_waitcnt vmcnt(0)" ::: "memory");
        }
    }
    __syncthreads();
}
constexpr int NTHR = 512;
#define XB_ST_OFF 131136
#define GSYNC() do { XcdBarrier xb_; xb_.bar = (unsigned*)(WSP + WS_CTL) + 1024; xb_.x = xb_xcc_id(); xb_.st = (volatile LAS unsigned*)(glds + XB_ST_OFF); xcd_barrier(xb_); } while (0)
#define INP(i) ((const float*)ldp_g(lds, (i), gbase))
#define OUTP ((float*)ldp_g(lds, 21, gbase))
#define WSP ((unsigned char*)ldp_g(lds, 22, gbase))

DI void conv_list_a(unsigned char* lds, const unsigned char* gbase, unsigned char* ws, int l, int wo_buf, int w0, int nw, int wave, int lane) {
    float* scr = (float*)(lds + wave * 8448);
    const float* w_in = INP(2) + (size_t)l * DM * DIN; const float* w_qb = INP(13) + (size_t)l * 384 * 576; const float* w_kvb = INP(15) + (size_t)l * 256 * 768; const float* w_out = INP(16) + (size_t)l * DM * DM;
    const float* g1 = INP(1) + l * DM; const float* gq = INP(12) + l * 384; const float* gkv = INP(14) + l * 256;
    us* Win_t = (us*)(ws + WS_WIN); us* Wqb_t = (us*)(ws + WS_WQB); us* Wkn_t = (us*)(ws + WS_WKN); us* Wv_t = (us*)(ws + WS_WV); us* Wout_t = (us*)(ws + (wo_buf ? WS_WOUT2 : WS_WOUT));
    constexpr int I_IN = 16 * 72, I_QB = 6 * 24, I_KN = 4 * 16, I_V = 4 * 16, I_OUT = 16 * 32, NIT = I_IN + I_QB + I_KN + I_V + I_OUT;
    for (int it = w0; it < NIT; it += nw) {
        int r = it;
        if (r < I_IN) { tr_item<1>(w_in, DM, DIN, Win_t, g1, scr, r, 72, lane); continue; } r -= I_IN;
        if (r < I_QB) { tr_item<2>(w_qb, 384, 576, Wqb_t, gq, scr, r, 24, lane); continue; } r -= I_QB;
        if (r < I_KN) { tr_item<3>(w_kvb, 256, 768, Wkn_t, gkv, scr, r, 16, lane); continue; } r -= I_KN;
        if (r < I_V) { tr_item<4>(w_kvb, 256, 768, Wv_t, gkv, scr, r, 16, lane); continue; } r -= I_V;
        tr_item_v4(w_out, DM, DM, Wout_t, nullptr, scr, r, 32, lane);
    }
}
DI void conv_list_b(unsigned char* lds, const unsigned char* gbase, unsigned char* ws, int l, int w0, int nw, int wave, int lane) {
    float* scr = (float*)(lds + wave * 8448);
    const float* w1 = INP(18) + (size_t)l * DM * FF; const float* w2 = INP(19) + (size_t)l * FF * DM; const float* g2 = INP(17) + l * DM;
    us* W1_t = (us*)(ws + WS_W1); us* W2_t = (us*)(ws + WS_W2);
    constexpr int I_1 = 16 * 128, I_2 = 64 * 32;
    for (int it = w0; it < I_1 + I_2; it += nw) {
        if (it < I_1) tr_item_v4(w1, DM, FF, W1_t, g2, scr, it, 128, lane);
        else tr_item_v4(w2, FF, DM, W2_t, nullptr, scr, it - I_1, 32, lane);
    }
}

__global__ void __launch_bounds__(NTHR, 2) fwd_megakernel(Params p) {
    extern __shared__ __attribute__((aligned(16))) unsigned char lds[];
    const int tid = threadIdx.x, lane = tid & 63, wave = __builtin_amdgcn_readfirstlane(tid >> 6);
    const int G = gridDim.x, bid = blockIdx.x, gw = bid * 8 + wave, NGW = G * 8;
    {
        unsigned long long* tab = (unsigned long long*)(lds + 131328);
        if (tid == 0) {
#pragma unroll
            for (int i = 0; i < 21; ++i) tab[i] = (unsigned long long)p.in[i];
            tab[21] = (unsigned long long)p.out; tab[22] = (unsigned long long)p.ws;
        }
        if (tid < 2) ((volatile unsigned*)(lds + XB_ST_OFF))[tid] = 0u;
        __syncthreads();
    }
    PG8_LAS unsigned char* glds = (PG8_LAS unsigned char*)lds;
    const unsigned char* gbase = p.ws;
    (void)xcd_barrier_post((unsigned*)(WSP + WS_CTL) + 1024, (volatile LAS unsigned*)(glds + XB_ST_OFF));

    {
        unsigned char* ws = WSP; float* ROPE = (float*)(ws + WS_ROPE);
        for (int idx = bid * NTHR + tid; idx < M * 16; idx += G * NTHR) {
            const int pos = idx >> 4, i = idx & 15;
            const float inv_freq = powf(10000.0f, -(float)i / 16.0f);
            const float ang = (float)pos * inv_freq;
            const double rev = (double)ang * 0.15915494309189535;
            const float fr = (float)(rev - rint(rev));
            ROPE[2 * idx] = __builtin_amdgcn_cosf(fr); ROPE[2 * idx + 1] = __builtin_amdgcn_sinf(fr);
        }
        conv_list_a(lds, gbase, ws, 0, 0, gw, NGW, wave, lane);
        x_to_bf16_ssq(INP(0), (us*)(ws + WS_XN), (float*)(ws + WS_SSQX), gw, NGW, lane);
    }
    if (gridDim.x == 0x7fffffffu) cg::this_grid().sync();
    GSYNC();

#pragma unroll 1
    for (int l = 0; l < NL; ++l) {
        {
            unsigned char* ws = WSP;
            pg8::Gemm g{(us*)(ws + WS_XN), (us*)(ws + WS_WIN), M, DINP, DM}; pg8::StaticOrder S; S.init(M, DINP, G, bid);
            EpiIn E{ws};
            prep_rstd(S, (const float*)(ws + WS_SSQX), (float*)(ws + WS_RSTD));
            pg8::gemm_phase<EpiIn, pg8::StaticOrder, true, true>(glds, g, S, E);
            __syncthreads();
            if (G > 64) { if (bid >= 64) conv_list_b(lds, gbase, ws, l, (bid - 64) * 8 + wave, (G - 64) * 8, wave, lane); }
            else conv_list_b(lds, gbase, ws, l, gw, NGW, wave, lane);
        }
        GSYNC();
        {
            unsigned char* ws = WSP;
            us* CQ = (us*)(ws + WS_CQ); us* CKV = (us*)(ws + WS_CKV); us* Q = (us*)(ws + WS_Q); us* K = (us*)(ws + WS_K); us* VT = (us*)(ws + WS_VT);
            float* SSQ = (float*)(ws + WS_SSQ); float* ROPE = (float*)(ws + WS_ROPE);
            { pg8::Gemm g{CQ, (us*)(ws + WS_WQB), M, 768, 384}; pg8::StaticOrder S; S.init(M, 768, G, bid); EpiQ E{Q, SSQ, ROPE}; pg8::gemm_phase<EpiQ, pg8::StaticOrder, true, true>(glds, g, S, E); }
            __syncthreads();
            { pg8::Gemm g{CKV, (us*)(ws + WS_WKN), M, 512, 256}; pg8::StaticOrder S; S.init(M, 512, G, (bid + 64) % G); EpiKn E{K, SSQ}; pg8::gemm_phase<EpiKn, pg8::StaticOrder, true, true>(glds, g, S, E); }
            __syncthreads();
            { pg8::Gemm g{(us*)(ws + WS_WV), CKV, 512, M, 256}; pg8::StaticOrder S; S.init(512, M, G, (bid + 192) % G); EpiVt E{VT, SSQ}; pg8::gemm_phase<EpiVt, pg8::StaticOrder, true, true>(glds, g, S, E); }
            __syncthreads();
            const float* cw = INP(6) + (size_t)l * 4 * 640; const float* cb = INP(7) + l * 640;
            for (int it = bid; it < 256; it += G)
                ssd_item(lds, it >> 1, it & 1, (us*)(ws + WS_XBC), (float*)(ws + WS_DT), cw, cb, INP(8) + l * 6, INP(9) + l * 6, INP(10) + l * 6,
                         (us*)OUTP  , (float*)(ws + WS_ST), (float*)(ws + WS_ACUM), (float*)(ws + WS_DEC), (us*)(ws + WS_CC));
            for (int it = bid; it < 512; it += G)
                gmlp_item(lds, it >> 2, it & 3, (us*)(ws + WS_U), (us*)(ws + WS_V), SSQ, INP(3) + l * 256, INP(4) + (size_t)l * 4 * 128 * 128, INP(5) + l * 4 * 128, (us*)(ws + WS_MIX));
        }
        GSYNC();
        {
            unsigned char* ws = WSP;
            float* ST = (float*)(ws + WS_ST); const float* DEC = (const float*)(ws + WS_DEC);
            int tl = threadIdx.x; asm volatile("" : "+v"(tl)); const int idx = bid * NTHR + tl;
            if (idx < 6 * 4096) {
                const int h = idx >> 12, pn = idx & 4095; float hs = 0.f;
#pragma unroll 1
                for (int c0 = 0; c0 < 128; c0 += 16) {
                    float tmp[16], dc[16];
#pragma unroll
                    for (int j = 0; j < 16; ++j) { tmp[j] = ST[((size_t)(c0 + j) * 6 + h) * 4096 + pn]; dc[j] = DEC[(c0 + j) * 8 + h]; }
#pragma unroll
                    for (int j = 0; j < 16; ++j) { ST[((size_t)(c0 + j) * 6 + h) * 4096 + pn] = hs; hs = dc[j] * hs + tmp[j]; }
                }
            }
            volatile unsigned* slot = (volatile unsigned*)(lds + 131200);
            {
            unsigned* qctr = (unsigned*)(ws + WS_CTL) + 64 * l;
            for (;;) {
                if (tid == 0) slot[0] = atomicAdd(qctr, 1u);
                __syncthreads();
                const unsigned uu = (unsigned)__builtin_amdgcn_readfirstlane((int)slot[0]);
                __syncthreads();
                if (uu >= (unsigned)ATT_ITEMS) break;
                int ah, aqb, akc; att_decode((int)uu, ah, aqb, akc);
                attn_unit(lds, (us*)(ws + WS_Q), (us*)(ws + WS_K), (us*)(ws + WS_VT), (us*)(ws + WS_MIX), (us*)(ws + 124 * MiB), (float*)(ws + 162 * MiB), ah, aqb, akc);
            }
            }
        }
        GSYNC();
        {
            unsigned char* ws = WSP;
            for (int it = bid; it < 288; it += G) attn_merge((const us*)(ws + 124 * MiB), (const float*)(ws + 162 * MiB), (us*)(ws + WS_MIX), it % 6, 16 + it / 6);
            for (int it = bid; it < 256; it += G)
                ssd_final_item(lds, it >> 1, it & 1, (us*)(ws + WS_CC), (float*)(ws + WS_ST), (us*)OUTP  , (float*)(ws + WS_ACUM), (us*)(ws + WS_ZS), INP(11) + l * 384, (us*)(ws + WS_MIX));
            if (l + 1 < NL) {
                if (G > 32) { if (bid >= 32) conv_list_a(lds, gbase, ws, l + 1, (l + 1) & 1, (bid - 32) * 8 + wave, (G - 32) * 8, wave, lane); }
                else conv_list_a(lds, gbase, ws, l + 1, (l + 1) & 1, gw, NGW, wave, lane);
            }
        }
        GSYNC();
        {
            unsigned char* ws = WSP;
            pg8::Gemm g{(us*)(ws + WS_MIX), (us*)(ws + ((l & 1) ? WS_WOUT2 : WS_WOUT)), M, DM, DM}; pg8::StaticOrder S; S.init(M, DM, G, bid);
            EpiRes E{(us*)(ws + WS_XN), (float*)(ws + WS_SSQX)};
            pg8::gemm_phase<EpiRes, pg8::StaticOrder, true, true>(glds, g, S, E);
        }
        GSYNC();
        {
            unsigned char* ws = WSP;
            pg8::Gemm g{(us*)(ws + WS_XN), (us*)(ws + WS_W1), M, FF, DM}; pg8::StaticOrder S; S.init(M, FF, G, bid); EpiRelu2 E{(us*)(ws + WS_H), (const float*)(ws + WS_RSTD)};
            prep_rstd(S, (const float*)(ws + WS_SSQX), (float*)(ws + WS_RSTD));
            pg8::gemm_phase<EpiRelu2, pg8::StaticOrder, true, true>(glds, g, S, E);
        }
        GSYNC();
        {
            unsigned char* ws = WSP;
            pg8::Gemm g{(us*)(ws + WS_H), (us*)(ws + WS_W2), M, DM, FF}; pg8::StaticOrder S; S.init(M, DM, G, bid);
            EpiRes E{(us*)(ws + WS_XN), (float*)(ws + WS_SSQX)};
            pg8::gemm_phase<EpiRes, pg8::StaticOrder, true, true>(glds, g, S, E);
        }
        GSYNC();
    }
    norm_rows_out((const us*)(WSP + WS_XN), OUTP, INP(20), gw, NGW, lane);
}

extern "C" void kernel_launch(void* const* d_in, const int* in_sizes, int n_in, void* d_out, int out_size, void* d_ws, size_t ws_size, hipStream_t stream) {
    static int grid = 0;
    if (grid == 0) {
        if (n_in != 21 || out_size != M * DM || ws_size < WS_END) { fprintf(stderr, "kernel_launch: unexpected shapes (n_in %d out %d ws %zu)\n", n_in, out_size, ws_size); grid = -1; return; }
        int dev = 0, cus = 0, per_cu = 0;
        (void)hipGetDevice(&dev); (void)hipDeviceGetAttribute(&cus, hipDeviceAttributeMultiprocessorCount, dev);
        (void)hipFuncSetAttribute((const void*)fwd_megakernel, hipFuncAttributeMaxDynamicSharedMemorySize, LDS_BYTES);
        (void)hipOccupancyMaxActiveBlocksPerMultiprocessor(&per_cu, (const void*)fwd_megakernel, NTHR, LDS_BYTES);
        if (per_cu < 1) { fprintf(stderr, "kernel_launch: occupancy query says %d blocks per CU\n", per_cu); per_cu = 1; }
        (void)hipGetLastError();
        grid = cus * per_cu;
    }
    if (grid < 0) return;
    (void)hipMemsetAsync((char*)d_ws + WS_CTL, 0, 32768, stream);
    Params p{};
    for (int i = 0; i < 21; ++i) p.in[i] = (const float*)d_in[i];
    p.out = (float*)d_out; p.ws = (unsigned char*)d_ws;
    void* args[] = {&p};
    hipError_t e = hipLaunchCooperativeKernel((const void*)fwd_megakernel, dim3(grid), dim3(NTHR), args, LDS_BYTES, stream);
    if (e != hipSuccess) fprintf(stderr, "cooperative launch failed: %s (grid %d)\n", hipGetErrorString(e), grid);
}
```

```cpp
#include <hip/hip_runtime.h>
#include <hip/hip_cooperative_groups.h>
#include <cstdio>
#include <cstdint>
namespace cg = cooperative_groups;
namespace pg8 {
#define PG8_LAS __attribute__((address_space(3)))
typedef unsigned short bf16_t;
typedef short bf16x8 __attribute__((ext_vector_type(8)));
typedef float f32x4 __attribute__((ext_vector_type(4)));
typedef unsigned u32x4 __attribute__((ext_vector_type(4)));
constexpr int BM = 256, BK = 64, HALF = 128, HTB = HALF * BK * 2  , STAGE_BYTES = 8 * HTB, NXCD = 8, WGM = 8;

__host__ __device__ __forceinline__ int lds_byte(int r, int c) { const int st = (r >> 4) * 2 + (c >> 5), rr = r & 15, cc = c & 31, ob = rr * 64 + cc * 2; return st * 1024 + (ob ^ (((ob >> 9) & 1) << 5)); }
__host__ __device__ __forceinline__ void stage_rc(int b, int& R, int& C) { const int st = b / 1024, sb = b % 1024, swz = sb ^ (((sb >> 9) & 1) << 5); R = (st >> 1) * 16 + swz / 64; C = (st & 1) * 32 + (swz % 64) / 2; }
__host__ __device__ __forceinline__ int perm32(int rho) { const int n = rho >> 4, i = rho & 15; return 8 * (i >> 2) + 4 * n + (i & 3); }

struct Unit { int pm, pn; };
struct Gemm { const bf16_t* A; const bf16_t* Bt; int M, N, K; };

struct StaticOrder {
    int nM, nN, nwg, G, c;
    __host__ __device__ void init(int M, int N, int G_, int c_) { nM = M / BM; nN = N / BM; nwg = nM * nN; G = G_; c = c_; }
    __host__ __device__ bool next(int i, Unit& u) const {
        const long L = (long)i * G + c; if (L >= nwg) return false;
        int wgid = (int)L; { const int q = nwg / NXCD, r = nwg % NXCD, xcd = wgid % NXCD, off = wgid / NXCD; wgid = (xcd < r ? xcd * (q + 1) : r * (q + 1) + (xcd - r) * q) + off; }
        const int nig = WGM * nN, gid = wgid / nig, fm = gid * WGM, gsz = (nM - fm) < WGM ? (nM - fm) : WGM;
        u.pm = fm + ((wgid % nig) % gsz); u.pn = (wgid % nig) / gsz; return true;
    }
    __device__ __forceinline__ void a_ready(const Unit&) const {}
    __device__ __forceinline__ void done(const Unit&) const {}
};

__device__ __forceinline__ unsigned cvt_pk_bf16(float lo, float hi) { unsigned r; asm volatile("v_cvt_pk_bf16_f32 %0, %1, %2" : "=v"(r) : "v"(lo), "v"(hi)); return r; }
template <class Epi, class Sched, bool ALIGN_EPI = false, bool SP2 = false>
__device__ __forceinline__ void gemm_phase(PG8_LAS unsigned char* lds, const Gemm g, const Sched& S, const Epi& E) {
    int tid_l = threadIdx.x; asm volatile("" : "+v"(tid_l));
    const int tid = tid_l, wid = __builtin_amdgcn_readfirstlane(tid >> 6), lane = tid & 63, wr = wid >> 2, wc = wid & 3, fr = lane & 15, fq = lane >> 4;
    int K_l = g.K; asm volatile("" : "+s"(K_l));
    const int K = K_l, nt = K / BK;
    unsigned voffA[2], voffB[2];
#pragma unroll
    for (int i = 0; i < 2; ++i) { int R, C; stage_rc(tid * 16 + i * 8192, R, C); const int Rb = Epi::PERM ? ((R & ~31) + perm32(R & 31)) : R;
        voffA[i] = (unsigned)(R * K + C) * 2u; voffB[i] = (unsigned)(Rb * K + C) * 2u; }
    const size_t kstep = (size_t)(BK * 2);
    const size_t hstep = (size_t)HALF * K * 2;
    const size_t tstep = 2 * hstep;
    const unsigned ldsw = (unsigned)wid * 1024u;
    const int aoff = lds_byte(wr * 64 + fr, fq * 8), boff = lds_byte(wc * 32 + fr, fq * 8);
#define PG8_SA(b, h) (((b) * 2 + (h)) * HTB)
#define PG8_SB(b, h) ((4 + (b) * 2 + (h)) * HTB)
#define PG8_STAGE(bufoff, gbase, voff) do { _Pragma("unroll") for (int _i = 0; _i < 2; ++_i) \
        __builtin_amdgcn_global_load_lds((const unsigned*)((const char*)(gbase) + (voff)[_i]), (PG8_LAS unsigned*)(lds + (bufoff) + ldsw + _i * 8192), 16, 0, 0); } while (0)
#define PG8_LDA(dst, b, h) do { _Pragma("unroll") for (int m = 0; m < 4; ++m) _Pragma("unroll") for (int k = 0; k < 2; ++k) dst[m][k] = *(const PG8_LAS bf16x8*)(lds + PG8_SA(b, h) + aoff + m * 2048 + k * 1024); } while (0)
#define PG8_LDB(dst, b, h) do { _Pragma("unroll") for (int n = 0; n < 2; ++n) _Pragma("unroll") for (int k = 0; k < 2; ++k) dst[n][k] = *(const PG8_LAS bf16x8*)(lds + PG8_SB(b, h) + boff + n * 2048 + k * 1024); } while (0)
#define PG8_MMA(ai, bj, At, Bt) do { __builtin_amdgcn_s_setprio(1); _Pragma("unroll") for (int m = 0; m < 4; ++m) _Pragma("unroll") for (int n = 0; n < 2; ++n) _Pragma("unroll") for (int k = 0; k < 2; ++k) \
        acc[ai][bj][m][n] = __builtin_amdgcn_mfma_f32_16x16x32_bf16(Bt[n][k], At[m][k], acc[ai][bj][m][n], 0, 0, 0); __builtin_amdgcn_s_setprio(0); } while (0)
#define PG8_WAIT_V(n) asm volatile("s_waitcnt vmcnt(" #n ")" ::: "memory")
#define PG8_WAIT_L(n) asm volatile("s_waitcnt lgkmcnt(" #n ")" ::: "memory")
#define PG8_BAR __builtin_amdgcn_s_barrier()
#define PG8_SCHED __builtin_amdgcn_sched_barrier(0)
    Unit cur, nxt; int ui = 0;
    if (!S.next(0, cur)) return;
    f32x4 acc[2][2][4][2];
#pragma unroll
    for (int a = 0; a < 2; ++a)
#pragma unroll
        for (int b = 0; b < 2; ++b)
#pragma unroll
            for (int m = 0; m < 4; ++m)
#pragma unroll
                for (int n = 0; n < 2; ++n) acc[a][b][m][n] = (f32x4){0.f, 0.f, 0.f, 0.f};
    bf16x8 At[4][2], B0[2][2], B1[2][2];
    const char* cA = (const char*)g.A + (size_t)cur.pm * tstep; const char* cB = (const char*)g.Bt + (size_t)cur.pn * tstep;
    S.a_ready(cur);
    if constexpr (SP2) {
        PG8_STAGE(PG8_SB(0, 0), cB, voffB); PG8_STAGE(PG8_SB(0, 1), cB + hstep, voffB); PG8_STAGE(PG8_SA(0, 0), cA, voffA); PG8_STAGE(PG8_SA(0, 1), cA + hstep, voffA);
        if (wr == 1) PG8_BAR;
        PG8_WAIT_V(2); PG8_BAR;
        PG8_STAGE(PG8_SB(1, 0), cB + kstep, voffB); PG8_STAGE(PG8_SA(1, 0), cA + kstep, voffA); PG8_STAGE(PG8_SB(1, 1), cB + hstep + kstep, voffB);
        PG8_WAIT_V(6); PG8_BAR;
    } else {
        PG8_STAGE(PG8_SB(0, 0), cB, voffB); PG8_STAGE(PG8_SA(0, 0), cA, voffA); PG8_STAGE(PG8_SB(0, 1), cB + hstep, voffB); PG8_STAGE(PG8_SA(0, 1), cA + hstep, voffA);
        if (wr == 1) PG8_BAR;
        PG8_WAIT_V(4); PG8_BAR;
        PG8_STAGE(PG8_SB(1, 0), cB + kstep, voffB); PG8_STAGE(PG8_SA(1, 0), cA + kstep, voffA); PG8_STAGE(PG8_SB(1, 1), cB + hstep + kstep, voffB);
        PG8_WAIT_V(6); PG8_BAR;
    }
    for (;;) {
        const bool has_next = S.next(ui + 1, nxt);
        const char* nA = has_next ? (const char*)g.A + (size_t)nxt.pm * tstep : cA; const char* nB = has_next ? (const char*)g.Bt + (size_t)nxt.pn * tstep : cB;
        for (int t = 0; t < nt; t += 2) {
            const bool last = (t == nt - 2);
            const char* a1 = cA + (size_t)(t + 1) * kstep;
            const char* a2 = last ? nA : cA + (size_t)(t + 2) * kstep; const char* b2 = last ? nB : cB + (size_t)(t + 2) * kstep;
            const char* a3 = a2 + kstep; const char* b3 = b2 + kstep;
            if (last && has_next) S.a_ready(nxt);
            if constexpr (SP2) {
            PG8_LDB(B0, 0, 0); PG8_LDB(B1, 0, 1); PG8_SCHED; PG8_LDA(At, 0, 0); PG8_STAGE(PG8_SA(1, 1), a1 + hstep, voffA);
            PG8_WAIT_V(8); PG8_WAIT_L(0); PG8_BAR; PG8_MMA(0, 0, At, B0); PG8_MMA(0, 1, At, B1); PG8_BAR; PG8_SCHED;
            PG8_LDA(At, 0, 1); PG8_STAGE(PG8_SB(0, 0), b2, voffB); PG8_STAGE(PG8_SB(0, 1), b2 + hstep, voffB); PG8_STAGE(PG8_SA(0, 0), a2, voffA);
            PG8_WAIT_V(8); PG8_WAIT_L(0); PG8_BAR; PG8_MMA(1, 0, At, B0); PG8_MMA(1, 1, At, B1); PG8_BAR; PG8_SCHED;
            PG8_LDB(B0, 1, 0); PG8_LDB(B1, 1, 1); PG8_SCHED; PG8_LDA(At, 1, 0); PG8_STAGE(PG8_SA(0, 1), a2 + hstep, voffA);
            PG8_WAIT_V(8); PG8_WAIT_L(0); PG8_BAR; PG8_MMA(0, 0, At, B0); PG8_MMA(0, 1, At, B1); PG8_BAR; PG8_SCHED;
            PG8_LDA(At, 1, 1); PG8_STAGE(PG8_SB(1, 0), b3, voffB); PG8_STAGE(PG8_SB(1, 1), b3 + hstep, voffB); PG8_STAGE(PG8_SA(1, 0), a3, voffA);
            PG8_WAIT_V(8); PG8_WAIT_L(0); PG8_BAR; PG8_MMA(1, 0, At, B0); PG8_MMA(1, 1, At, B1); PG8_BAR; PG8_SCHED;
            } else {
            PG8_LDB(B0, 0, 0); PG8_SCHED; PG8_LDA(At, 0, 0); PG8_STAGE(PG8_SA(1, 1), a1 + hstep, voffA);
            PG8_WAIT_L(8); PG8_BAR; PG8_WAIT_L(0); PG8_MMA(0, 0, At, B0); PG8_BAR; PG8_SCHED;
            PG8_LDB(B1, 0, 1); PG8_STAGE(PG8_SB(0, 0), b2, voffB);
            PG8_BAR; PG8_WAIT_L(0); PG8_MMA(0, 1, At, B1); PG8_BAR;
            PG8_LDA(At, 0, 1); PG8_STAGE(PG8_SA(0, 0), a2, voffA);
            PG8_BAR; PG8_WAIT_L(0); PG8_MMA(1, 0, At, B0); PG8_BAR; PG8_SCHED;
            PG8_STAGE(PG8_SB(0, 1), b2 + hstep, voffB);
            PG8_WAIT_V(6); PG8_BAR; PG8_MMA(1, 1, At, B1); PG8_BAR;
            PG8_LDB(B0, 1, 0); PG8_SCHED; PG8_LDA(At, 1, 0); PG8_STAGE(PG8_SA(0, 1), a2 + hstep, voffA);
            PG8_WAIT_L(8); PG8_BAR; PG8_WAIT_L(0); PG8_MMA(0, 0, At, B0); PG8_BAR; PG8_SCHED;
            PG8_LDB(B1, 1, 1); PG8_STAGE(PG8_SB(1, 0), b3, voffB);
            PG8_BAR; PG8_WAIT_L(0); PG8_MMA(0, 1, At, B1); PG8_BAR;
            PG8_LDA(At, 1, 1); PG8_STAGE(PG8_SA(1, 0), a3, voffA);
            PG8_BAR; PG8_WAIT_L(0); PG8_MMA(1, 0, At, B0); PG8_BAR; PG8_SCHED;
            PG8_STAGE(PG8_SB(1, 1), b3 + hstep, voffB);
            PG8_WAIT_V(6); PG8_BAR; PG8_MMA(1, 1, At, B1); PG8_BAR;
            }
        }
        if constexpr (ALIGN_EPI) { if (wr == 0) PG8_BAR; }
        if constexpr (!Epi::AFTER_DRAIN) { E(acc, cur, wr, wc, fr, fq); S.done(cur); }
        if (!has_next) break;
#pragma unroll
        for (int a = 0; a < 2; ++a)
#pragma unroll
            for (int b = 0; b < 2; ++b)
#pragma unroll
                for (int m = 0; m < 4; ++m)
#pragma unroll
                    for (int n = 0; n < 2; ++n) acc[a][b][m][n] = (f32x4){0.f, 0.f, 0.f, 0.f};
        cur = nxt; cA = nA; cB = nB; ++ui;
        if constexpr (ALIGN_EPI) { if (wr == 1) PG8_BAR; }
    }
    PG8_WAIT_V(0);
    if constexpr (!ALIGN_EPI) { if (wr == 0) PG8_BAR; }
    PG8_BAR;
    if constexpr (Epi::AFTER_DRAIN) { E.fused(acc, cur, wr, wc, fr, fq, lds, wid, lane); S.done(cur); }
#undef PG8_SA
#undef PG8_SB
#undef PG8_STAGE
#undef PG8_LDA
#undef PG8_LDB
#undef PG8_MMA
#undef PG8_WAIT_V
#undef PG8_WAIT_L
#undef PG8_BAR
#undef PG8_SCHED
}
}

#ifndef PG8_SP2
#define PG8_SP2 true
#endif
#ifndef PG8_ALIGN
#define PG8_ALIGN true
#endif
#define DI __device__ __forceinline__
typedef unsigned short us;
typedef short bf16x8 __attribute__((ext_vector_type(8)));
typedef short s16x4 __attribute__((ext_vector_type(4)));
typedef float f32x4 __attribute__((ext_vector_type(4)));
typedef float f32x16 __attribute__((ext_vector_type(16)));
typedef unsigned u32x4 __attribute__((ext_vector_type(4)));
typedef unsigned u32x2 __attribute__((ext_vector_type(2)));
#define MFMA32(a, b, c) __builtin_amdgcn_mfma_f32_32x32x16_bf16((a), (b), (c), 0, 0, 0)

constexpr int M = 16384, DM = 1024, NL = 4, FF = 4096, DINP = 2304, DIN = 2214;
constexpr float EPS = 1e-6f;
constexpr size_t MiB = 1u << 20;
constexpr size_t WS_CTL = 0, WS_ROPE = 1 * MiB, WS_SSQ = 3 * MiB, WS_DT = 5 * MiB, WS_ACUM = 5 * MiB + 512 * 1024, WS_DEC = 6 * MiB;
constexpr size_t WS_WIN = 8 * MiB, WS_WQB = 12 * MiB + 512 * 1024, WS_WKN = 13 * MiB + 256 * 1024, WS_WV = 13 * MiB + 512 * 1024, WS_WOUT = 14 * MiB, WS_W1 = 16 * MiB, WS_W2 = 24 * MiB;
constexpr size_t WS_XN = 32 * MiB, WS_Y = 32 * MiB  , WS_MIX = 64 * MiB, WS_H = 96 * MiB;
constexpr size_t WS_U = 96 * MiB, WS_V = 104 * MiB, WS_ZS = 112 * MiB, WS_XBC = 124 * MiB, WS_CQ = 144 * MiB, WS_CKV = 156 * MiB, WS_Q = 164 * MiB, WS_K = 182 * MiB, WS_VT = 200 * MiB, WS_CC = 212 * MiB;
constexpr size_t WS_ST = 224 * MiB, WS_SSQX = 236 * MiB, WS_WOUT2 = 238 * MiB, WS_RSTD = 240 * MiB, WS_END = 241 * MiB;
constexpr int LDS_BYTES = 147456;
constexpr float QSCALE = 0.10206207261596575f * 1.4426950408889634f;

DI float bf2f(us b) { return __uint_as_float(((unsigned)b) << 16); }
typedef __bf16 bf16x2_t __attribute__((ext_vector_type(2)));
typedef float f32x2_t __attribute__((ext_vector_type(2)));
DI unsigned pk2(float lo, float hi) { f32x2_t v = {lo, hi}; bf16x2_t b = __builtin_convertvector(v, bf16x2_t); return __builtin_bit_cast(unsigned, b); }
DI us f2bf(float f) { return (us)(pk2(f, 0.f) & 0xffffu); }
DI int crow(int i, int hf) { return (i & 3) + 8 * (i >> 2) + 4 * hf; }
DI float wave_sum(float v) {
#pragma unroll
    for (int o = 1; o < 64; o <<= 1) v += __shfl_xor(v, o);
    return v;
}
DI float gelu_tanh(float x) { const float u = 0.7978845608028654f * (x + 0.044715f * x * x * x); return x * __builtin_amdgcn_rcpf(1.f + __builtin_amdgcn_exp2f(-2.885390081777927f * u)); }
DI float silu(float x) { return x * __builtin_amdgcn_rcpf(1.f + __builtin_amdgcn_exp2f(-1.4426950408889634f * x)); }
DI float softplus(float x) { return x > 20.f ? x : log1pf(__expf(x)); }
DI int rope_src(int j) { const int g = j >> 3, w = j & 7, i = g * 4 + (w & 3); return (w < 4) ? i : 16 + i; }
#define LDS_WAIT() asm volatile("s_waitcnt lgkmcnt(0)" ::: "memory")

DI void mm32(f32x16& acc, const us* A, int lda, const us* B, int ldb, int ksteps, int lane) {
    const int r = lane & 31, hf = lane >> 5;
    const us* ap = A + r * lda + 8 * hf; const us* bp = B + r * ldb + 8 * hf;
    for (int ks = 0; ks < ksteps; ++ks) { const bf16x8 a = *(const bf16x8*)(ap + 16 * ks); const bf16x8 b = *(const bf16x8*)(bp + 16 * ks); acc = MFMA32(a, b, acc); }
}

struct Params { const float* in[21]; float* out; unsigned char* ws; };

template <int MODE> DI int src_col(int r) {
    if (MODE == 0) return r;
    if (MODE == 1) { if (r < 1536) return r; if (r < 2176) return r + 6; if (r < 2208) return 2182 + rope_src(r - 2176); if (r < 2214) return 1536 + (r - 2208); return -1; }
    if (MODE == 2) { if (r >= 576) return -1; const int hd = r / 96, w = r % 96; return w < 64 ? r : hd * 96 + 64 + rope_src(w - 64); }
    if (MODE == 3) { if (r >= 384) return -1; return (r >> 6) * 128 + (r & 63); }
    if (r >= 384) return -1; return (r >> 6) * 128 + 64 + (r & 63);
}
template <int MODE> DI void tr_item(const float* __restrict__ W, int K, int Nsrc, us* WT, const float* gk, float* scr, int item, int nblk, int lane) {
    asm volatile("" : "+v"(lane));
    const int kb = item / nblk, nb = item % nblk, k0 = 64 * kb, n0 = 32 * nb;
    const int sc = src_col<MODE>(n0 + (lane & 31));
#pragma unroll
    for (int i = 0; i < 32; ++i) { const int kk = 2 * i + (lane >> 5); float v = sc >= 0 ? W[(size_t)(k0 + kk) * Nsrc + sc] : 0.f; if (gk) v *= gk[k0 + kk]; scr[kk * 33 + (lane & 31)] = v; }
    LDS_WAIT();
    const int c = lane & 7;
#pragma unroll
    for (int j = 0; j < 4; ++j) { const int n = (lane >> 3) + 8 * j; const float* s = scr + (8 * c) * 33 + n;
        u32x4 o; o.x = pk2(s[0 * 33], s[1 * 33]); o.y = pk2(s[2 * 33], s[3 * 33]); o.z = pk2(s[4 * 33], s[5 * 33]); o.w = pk2(s[6 * 33], s[7 * 33]);
        *(u32x4*)(WT + (size_t)(n0 + n) * K + k0 + 8 * c) = o; }
    LDS_WAIT();
}

DI void tr_item_v4(const float* __restrict__ W, int K, int N, us* WT, const float* gk, float* scr, int item, int nblk, int lane) {
    asm volatile("" : "+v"(lane));
    const int kb = item / nblk, nb = item % nblk, k0 = 64 * kb, n0 = 32 * nb, kr = lane >> 3, n4 = 4 * (lane & 7);
    f32x4 v[8];
#pragma unroll
    for (int j = 0; j < 8; ++j) v[j] = *(const f32x4*)(W + (size_t)(k0 + 8 * j + kr) * N + n0 + n4);
#pragma unroll
    for (int j = 0; j < 8; ++j) { const int kk = 8 * j + kr; const float gsc = gk ? gk[k0 + kk] : 1.f;
        scr[kk * 33 + n4] = v[j][0] * gsc; scr[kk * 33 + n4 + 1] = v[j][1] * gsc; scr[kk * 33 + n4 + 2] = v[j][2] * gsc; scr[kk * 33 + n4 + 3] = v[j][3] * gsc; }
    LDS_WAIT();
    const int c = lane & 7;
#pragma unroll
    for (int j = 0; j < 4; ++j) { const int n = (lane >> 3) + 8 * j; const float* s = scr + (8 * c) * 33 + n;
        u32x4 o; o.x = pk2(s[0 * 33], s[1 * 33]); o.y = pk2(s[2 * 33], s[3 * 33]); o.z = pk2(s[4 * 33], s[5 * 33]); o.w = pk2(s[6 * 33], s[7 * 33]);
        *(u32x4*)(WT + (size_t)(n0 + n) * K + k0 + 8 * c) = o; }
    LDS_WAIT();
}

DI void norm_rows_bf16(const float* x, const float* g, us* XN, int gw, int NGW, int lane) {
    asm volatile("" : "+v"(lane));
    f32x4 gv[4];
#pragma unroll
    for (int j = 0; j < 4; ++j) gv[j] = *(const f32x4*)(g + 4 * lane + 256 * j);
    for (int m = gw; m < M; m += NGW) {
        const f32x4* xr = (const f32x4*)(x + (size_t)m * DM) + lane;
        f32x4 v[4]; float s = 0.f;
#pragma unroll
        for (int j = 0; j < 4; ++j) { v[j] = xr[64 * j]; s += (v[j].x * v[j].x + v[j].y * v[j].y) + (v[j].z * v[j].z + v[j].w * v[j].w); }
        const float rstd = rsqrtf(wave_sum(s) * (1.f / DM) + EPS);
        u32x2* o = (u32x2*)(XN + (size_t)m * DM) + lane;
#pragma unroll
        for (int j = 0; j < 4; ++j) { u32x2 w; w.x = pk2(v[j].x * rstd * gv[j].x, v[j].y * rstd * gv[j].y); w.y = pk2(v[j].z * rstd * gv[j].z, v[j].w * rstd * gv[j].w); o[64 * j] = w; }
    }
}
DI void x_to_bf16_ssq(const float* x, us* XB, float* SSQX, int gw, int NGW, int lane) {
    asm volatile("" : "+v"(lane));
    for (int m = gw; m < M; m += NGW) {
        const f32x4* xr = (const f32x4*)(x + (size_t)m * DM) + lane;
        f32x4 v[4]; float s = 0.f;
#pragma unroll
        for (int j = 0; j < 4; ++j) { v[j] = xr[64 * j]; s += (v[j].x * v[j].x + v[j].y * v[j].y) + (v[j].z * v[j].z + v[j].w * v[j].w); }
        s = wave_sum(s);
        u32x2* o = (u32x2*)(XB + (size_t)m * DM) + lane;
#pragma unroll
        for (int j = 0; j < 4; ++j) { u32x2 w; w.x = pk2(v[j].x, v[j].y); w.y = pk2(v[j].z, v[j].w); o[64 * j] = w; }
        if (lane < 32) SSQX[m * 32 + lane] = lane == 0 ? s : 0.f;
    }
}
DI void norm_rows_out(const us* xb, float* out, const float* g, int gw, int NGW, int lane) {
    asm volatile("" : "+v"(lane));
    f32x4 gv[4];
#pragma unroll
    for (int j = 0; j < 4; ++j) gv[j] = *(const f32x4*)(g + 4 * lane + 256 * j);
    for (int m = gw; m < M; m += NGW) {
        const u32x2* xr = (const u32x2*)(xb + (size_t)m * DM) + lane;
        f32x4 v[4]; float s = 0.f;
#pragma unroll
        for (int j = 0; j < 4; ++j) { const u32x2 w = xr[64 * j]; v[j] = (f32x4){__uint_as_float(w.x << 16), __uint_as_float(w.x & 0xffff0000u), __uint_as_float(w.y << 16), __uint_as_float(w.y & 0xffff0000u)};
            s += (v[j].x * v[j].x + v[j].y * v[j].y) + (v[j].z * v[j].z + v[j].w * v[j].w); }
        const float rstd = rsqrtf(wave_sum(s) * (1.f / DM) + EPS);
        f32x4* o = (f32x4*)(out + (size_t)m * DM) + lane;
#pragma unroll
        for (int j = 0; j < 4; ++j) o[64 * j] = v[j] * rstd * gv[j];
    }
}

using pg8::Unit;
DI void st_bf16x8(us* p, f32x4 a, f32x4 b) { u32x4 w; w.x = pk2(a[0], a[1]); w.y = pk2(a[2], a[3]); w.z = pk2(b[0], b[1]); w.w = pk2(b[2], b[3]); *(u32x4*)p = w; }
DI float sq8(f32x4 a, f32x4 b) { return (a[0] * a[0] + a[1] * a[1]) + (a[2] * a[2] + a[3] * a[3]) + (b[0] * b[0] + b[1] * b[1]) + (b[2] * b[2] + b[3] * b[3]); }

DI float rstd_x(const float* SSQX, int row) {
    const f32x4* p = (const f32x4*)(SSQX + (size_t)row * 32); f32x4 s = p[0];
#pragma unroll
    for (int j = 1; j < 8; ++j) s += p[j];
    return rsqrtf(((s[0] + s[1]) + (s[2] + s[3])) * (1.f / DM) + EPS);
}
DI void prep_rstd(const pg8::StaticOrder& S, const float* SSQX, float* RSTD) {
    int tid = threadIdx.x; asm volatile("" : "+v"(tid));
    Unit u;
    for (int i = 0; S.next(i, u); ++i) {
        const int row = u.pm * 256 + (tid >> 1);
        const f32x4* p = (const f32x4*)(SSQX + (size_t)row * 32 + (tid & 1) * 16);
        const f32x4 s = (p[0] + p[1]) + (p[2] + p[3]);
        float t = (s[0] + s[1]) + (s[2] + s[3]); t += __shfl_xor(t, 1);
        if ((tid & 1) == 0) RSTD[row] = rsqrtf(t * (1.f / DM) + EPS);
    }
    asm volatile("s_waitcnt vmcnt(0)" ::: "memory");
    __syncthreads();
}
struct EpiIn {
    static constexpr bool PERM = true, AFTER_DRAIN = false;
    unsigned char* ws;
    DI void operator()(const f32x4 (&acc)[2][2][4][2], const Unit& u, int wr, int wc, int fr, int fq) const {
        asm volatile("" : "+v"(fr), "+v"(fq));
        us* U = (us*)(ws + WS_U); us* V = (us*)(ws + WS_V); us* ZS = (us*)(ws + WS_ZS); us* XBC = (us*)(ws + WS_XBC); us* CQ = (us*)(ws + WS_CQ); us* CKV = (us*)(ws + WS_CKV); us* K = (us*)(ws + WS_K);
        float* SSQ = (float*)(ws + WS_SSQ); float* DT = (float*)(ws + WS_DT); const float* rope = (const float*)(ws + WS_ROPE);
        float rxa[2][4];
#pragma unroll
        for (int ai = 0; ai < 2; ++ai)
#pragma unroll
            for (int m = 0; m < 4; ++m) rxa[ai][m] = ((const float*)(ws + WS_RSTD))[u.pm * 256 + ai * 128 + wr * 64 + m * 16 + fr];
#pragma unroll
        for (int bj = 0; bj < 2; ++bj) {
            const int sg = 2 * u.pn + bj, c0 = 32 * wc + 8 * fq;
#pragma unroll
            for (int ai = 0; ai < 2; ++ai)
#pragma unroll
                for (int m = 0; m < 4; ++m) {
                    const int row = u.pm * 256 + ai * 128 + wr * 64 + m * 16 + fr;
                    const float rx = rxa[ai][m];
                    f32x4 v0 = acc[ai][bj][m][0] * rx, v1 = acc[ai][bj][m][1] * rx;
                    if (sg < 4) {
#pragma unroll
                        for (int e = 0; e < 4; ++e) { v0[e] = gelu_tanh(v0[e]); v1[e] = gelu_tanh(v1[e]); }
                        st_bf16x8((sg < 2 ? U : V) + (size_t)row * 256 + (sg & 1) * 128 + c0, v0, v1);
                        if (sg >= 2) { float s = sq8(v0, v1); s += __shfl_xor(s, 16); s += __shfl_xor(s, 32); if (fq == 0) SSQ[row * 32 + (sg - 2) * 4 + wc] = s; }
                    } else if (sg < 7) {
#pragma unroll
                        for (int e = 0; e < 4; ++e) { v0[e] = silu(v0[e]); v1[e] = silu(v1[e]); }
                        st_bf16x8(ZS + (size_t)row * 384 + (sg - 4) * 128 + c0, v0, v1);
                    } else if (sg < 12) {
                        st_bf16x8(XBC + (size_t)row * 640 + (sg - 7) * 128 + c0, v0, v1);
                    } else if (sg < 15) {
                        st_bf16x8(CQ + (size_t)row * 384 + (sg - 12) * 128 + c0, v0, v1);
                        float s = sq8(v0, v1); s += __shfl_xor(s, 16); s += __shfl_xor(s, 32); if (fq == 0) SSQ[row * 32 + 8 + (sg - 12) * 4 + wc] = s;
                    } else if (sg < 17) {
                        st_bf16x8(CKV + (size_t)row * 256 + (sg - 15) * 128 + c0, v0, v1);
                        float s = sq8(v0, v1); s += __shfl_xor(s, 16); s += __shfl_xor(s, 32); if (fq == 0) SSQ[row * 32 + 20 + (sg - 15) * 4 + wc] = s;
                    } else {
                        if (wc == 0) {
                            const f32x4 cs0 = *(const f32x4*)(rope + (size_t)row * 32 + 8 * fq), cs1 = *(const f32x4*)(rope + (size_t)row * 32 + 8 * fq + 4);
                            const float c[4] = {cs0[0], cs0[2], cs1[0], cs1[2]}, s[4] = {cs0[1], cs0[3], cs1[1], cs1[3]};
                            f32x4 o1, o2;
#pragma unroll
                            for (int e = 0; e < 4; ++e) { o1[e] = v0[e] * c[e] - v1[e] * s[e]; o2[e] = v1[e] * c[e] + v0[e] * s[e]; }
#pragma unroll
                            for (int hd = 0; hd < 6; ++hd) st_bf16x8(K + ((size_t)hd * M + row) * 96 + 64 + 8 * fq, o1, o2);
                        } else if (wc == 1 && fq == 0) { *(f32x4*)(DT + row * 8) = v0; *(f32x4*)(DT + row * 8 + 4) = v1; }
                    }
                }
        }
    }
};
struct EpiQ {
    static constexpr bool PERM = true, AFTER_DRAIN = false;
    us* Q; const float* SSQ; const float* rope;
    DI void operator()(const f32x4 (&acc)[2][2][4][2], const Unit& u, int wr, int wc, int fr, int fq) const {
        asm volatile("" : "+v"(fr), "+v"(fq));
#pragma unroll
        for (int ai = 0; ai < 2; ++ai)
#pragma unroll
            for (int m = 0; m < 4; ++m) {
                const int row = u.pm * 256 + ai * 128 + wr * 64 + m * 16 + fr;
                const f32x4 a = *(const f32x4*)(SSQ + row * 32 + 8), b = *(const f32x4*)(SSQ + row * 32 + 12), c = *(const f32x4*)(SSQ + row * 32 + 16);
                const float ss = ((a[0] + a[1]) + (a[2] + a[3])) + ((b[0] + b[1]) + (b[2] + b[3])) + ((c[0] + c[1]) + (c[2] + c[3]));
                const float sc = rsqrtf(ss * (1.f / 384.f) + EPS) * QSCALE;
#pragma unroll
                for (int bj = 0; bj < 2; ++bj) {
                    const int colb = u.pn * 256 + bj * 128 + 32 * wc;
                    if (colb >= 576) continue;
                    f32x4 v0 = acc[ai][bj][m][0] * sc, v1 = acc[ai][bj][m][1] * sc;
                    if ((colb >> 5) % 3 == 2) {
                        const f32x4 cs0 = *(const f32x4*)(rope + (size_t)row * 32 + 8 * fq), cs1 = *(const f32x4*)(rope + (size_t)row * 32 + 8 * fq + 4);
                        const float cc[4] = {cs0[0], cs0[2], cs1[0], cs1[2]}, sn[4] = {cs0[1], cs0[3], cs1[1], cs1[3]};
                        f32x4 o1, o2;
#pragma unroll
                        for (int e = 0; e < 4; ++e) { o1[e] = v0[e] * cc[e] - v1[e] * sn[e]; o2[e] = v1[e] * cc[e] + v0[e] * sn[e]; }
                        v0 = o1; v1 = o2;
                    }
                    st_bf16x8(Q + ((size_t)(colb / 96) * M + row) * 96 + (colb % 96) + 8 * fq, v0, v1);
                }
            }
    }
};
struct EpiKn {
    static constexpr bool PERM = true, AFTER_DRAIN = false;
    us* K; const float* SSQ;
    DI void operator()(const f32x4 (&acc)[2][2][4][2], const Unit& u, int wr, int wc, int fr, int fq) const {
        asm volatile("" : "+v"(fr), "+v"(fq));
#pragma unroll
        for (int ai = 0; ai < 2; ++ai)
#pragma unroll
            for (int m = 0; m < 4; ++m) {
                const int row = u.pm * 256 + ai * 128 + wr * 64 + m * 16 + fr;
                const f32x4 a = *(const f32x4*)(SSQ + row * 32 + 20), b = *(const f32x4*)(SSQ + row * 32 + 24);
                const float sc = rsqrtf((((a[0] + a[1]) + (a[2] + a[3])) + ((b[0] + b[1]) + (b[2] + b[3]))) * (1.f / 256.f) + EPS);
#pragma unroll
                for (int bj = 0; bj < 2; ++bj) {
                    const int col = u.pn * 256 + bj * 128 + 32 * wc + 8 * fq;
                    if (col >= 384) continue;
                    st_bf16x8(K + ((size_t)(col >> 6) * M + row) * 96 + (col & 63), acc[ai][bj][m][0] * sc, acc[ai][bj][m][1] * sc);
                }
            }
    }
};
struct EpiVt {
    static constexpr bool PERM = true, AFTER_DRAIN = false;
    us* VT; const float* SSQ;
    DI void operator()(const f32x4 (&acc)[2][2][4][2], const Unit& u, int wr, int wc, int fr, int fq) const {
        asm volatile("" : "+v"(fr), "+v"(fq));
#pragma unroll
        for (int bj = 0; bj < 2; ++bj) {
            const int tok0 = u.pn * 256 + bj * 128 + 32 * wc + 8 * fq;
            float rs[8];
#pragma unroll
            for (int e = 0; e < 8; ++e) { const f32x4 a = *(const f32x4*)(SSQ + (tok0 + e) * 32 + 20), b = *(const f32x4*)(SSQ + (tok0 + e) * 32 + 24);
                rs[e] = rsqrtf((((a[0] + a[1]) + (a[2] + a[3])) + ((b[0] + b[1]) + (b[2] + b[3]))) * (1.f / 256.f) + EPS); }
#pragma unroll
            for (int ai = 0; ai < 2; ++ai)
#pragma unroll
                for (int m = 0; m < 4; ++m) {
                    const int f = u.pm * 256 + ai * 128 + wr * 64 + m * 16 + fr;
                    if (f >= 384) continue;
                    f32x4 v0 = acc[ai][bj][m][0], v1 = acc[ai][bj][m][1];
#pragma unroll
                    for (int e = 0; e < 4; ++e) { v0[e] *= rs[e]; v1[e] *= rs[4 + e]; }
                    st_bf16x8(VT + (size_t)f * M + tok0, v0, v1);
                }
        }
    }
};
struct EpiRes {
    static constexpr bool PERM = true, AFTER_DRAIN = false;
    us* XB; float* SSQX;
    DI void operator()(const f32x4 (&acc)[2][2][4][2], const Unit& u, int wr, int wc, int fr, int fq) const {
        asm volatile("" : "+v"(fr), "+v"(fq));
#pragma unroll
        for (int ai = 0; ai < 2; ++ai)
#pragma unroll
            for (int m = 0; m < 4; ++m) {
                const int row = u.pm * 256 + ai * 128 + wr * 64 + m * 16 + fr;
#pragma unroll
                for (int bj = 0; bj < 2; ++bj) {
                    const size_t o = (size_t)row * DM + u.pn * 256 + bj * 128 + 32 * wc + 8 * fq;
                    const u32x4 xv = *(const u32x4*)(XB + o);
                    const f32x4 x0 = (f32x4){__uint_as_float(xv.x << 16), __uint_as_float(xv.x & 0xffff0000u), __uint_as_float(xv.y << 16), __uint_as_float(xv.y & 0xffff0000u)} + acc[ai][bj][m][0];
                    const f32x4 x1 = (f32x4){__uint_as_float(xv.z << 16), __uint_as_float(xv.z & 0xffff0000u), __uint_as_float(xv.w << 16), __uint_as_float(xv.w & 0xffff0000u)} + acc[ai][bj][m][1];
                    st_bf16x8(XB + o, x0, x1);
                    float s = sq8(x0, x1); s += __shfl_xor(s, 16); s += __shfl_xor(s, 32);
                    if (fq == 0) SSQX[row * 32 + u.pn * 8 + bj * 4 + wc] = s;
                }
            }
    }
};
struct EpiRelu2 {
    static constexpr bool PERM = true, AFTER_DRAIN = false;
    us* H; const float* RSTD;
    DI void operator()(const f32x4 (&acc)[2][2][4][2], const Unit& u, int wr, int wc, int fr, int fq) const {
        asm volatile("" : "+v"(fr), "+v"(fq));
        float rxa[2][4];
#pragma unroll
        for (int ai = 0; ai < 2; ++ai)
#pragma unroll
            for (int m = 0; m < 4; ++m) rxa[ai][m] = RSTD[u.pm * 256 + ai * 128 + wr * 64 + m * 16 + fr];
#pragma unroll
        for (int ai = 0; ai < 2; ++ai)
#pragma unroll
            for (int m = 0; m < 4; ++m) {
                const int row = u.pm * 256 + ai * 128 + wr * 64 + m * 16 + fr;
                const float rx = rxa[ai][m];
#pragma unroll
                for (int bj = 0; bj < 2; ++bj) {
                    f32x4 v0 = acc[ai][bj][m][0], v1 = acc[ai][bj][m][1];
#pragma unroll
                    for (int e = 0; e < 4; ++e) { const float a = fmaxf(v0[e], 0.f) * rx, b = fmaxf(v1[e], 0.f) * rx; v0[e] = a * a; v1[e] = b * b; }
                    st_bf16x8(H + (size_t)row * FF + u.pn * 256 + bj * 128 + 32 * wc + 8 * fq, v0, v1);
                }
            }
    }
};
DI void ld16bf(const us* p, float* o) {
    const u32x4 a = *(const u32x4*)p, b = *(const u32x4*)(p + 8);
    const unsigned w[8] = {a.x, a.y, a.z, a.w, b.x, b.y, b.z, b.w};
#pragma unroll
    for (int j = 0; j < 8; ++j) { o[2 * j] = __uint_as_float(w[j] << 16); o[2 * j + 1] = __uint_as_float(w[j] & 0xffff0000u); }
}
DI void conv16(const us* XBC, int row, int col, const float* cw, const float* cb, float* o) {
#pragma unroll
    for (int j = 0; j < 16; ++j) o[j] = cb[col + j];
#pragma unroll
    for (int k = 0; k < 4; ++k) {
        const int r = row - 3 + k;
        if (r >= 0) { float x[16]; ld16bf(XBC + (size_t)r * 640 + col, x);
#pragma unroll
            for (int j = 0; j < 16; ++j) o[j] += cw[k * 640 + col + j] * x[j]; }
    }
#pragma unroll
    for (int j = 0; j < 16; ++j) o[j] = silu(o[j]);
}
DI void st16bf(us* p, const float* o) {
    u32x4 a, b; a.x = pk2(o[0], o[1]); a.y = pk2(o[2], o[3]); a.z = pk2(o[4], o[5]); a.w = pk2(o[6], o[7]); b.x = pk2(o[8], o[9]); b.y = pk2(o[10], o[11]); b.z = pk2(o[12], o[13]); b.w = pk2(o[14], o[15]);
    *(u32x4*)p = a; *(u32x4*)(p + 8) = b;
}

struct ConvIn { u32x2 v[7]; f32x4 w[4]; f32x4 b; };
DI void conv4x4_load(ConvIn& ci, const us* XBC, int row0, int col, const float* cw, const float* cb) {
#pragma unroll
    for (int r7 = 0; r7 < 7; ++r7) { const int rr = row0 - 3 + r7; ci.v[r7] = (u32x2){0u, 0u}; if (rr >= 0) ci.v[r7] = *(const u32x2*)(XBC + (size_t)rr * 640 + col); }
#pragma unroll
    for (int k = 0; k < 4; ++k) ci.w[k] = *(const f32x4*)(cw + k * 640 + col);
    ci.b = *(const f32x4*)(cb + col);
}
DI void conv4x4_compute(const ConvIn& ci, float (&o)[4][4]) {
    float x[7][4];
#pragma unroll
    for (int r7 = 0; r7 < 7; ++r7) { const u32x2 v = ci.v[r7];
        x[r7][0] = __uint_as_float(v.x << 16); x[r7][1] = __uint_as_float(v.x & 0xffff0000u); x[r7][2] = __uint_as_float(v.y << 16); x[r7][3] = __uint_as_float(v.y & 0xffff0000u); }
#pragma unroll
    for (int tt = 0; tt < 4; ++tt)
#pragma unroll
        for (int j = 0; j < 4; ++j) o[tt][j] = silu(ci.b[j] + (ci.w[0][j] * x[tt][j] + ci.w[1][j] * x[tt + 1][j]) + (ci.w[2][j] * x[tt + 2][j] + ci.w[3][j] * x[tt + 3][j]));
}
DI void conv4x4(const us* XBC, int row0, int col, const float* cw, const float* cb, float (&o)[4][4]) { ConvIn ci; conv4x4_load(ci, XBC, row0, col, cw, cb); conv4x4_compute(ci, o); }
DI u32x2 pk4(float a, float b, float c, float d) { u32x2 r; r.x = pk2(a, b); r.y = pk2(c, d); return r; }
DI void ssd_item(unsigned char* smem, int c, int g, const us* XBC, const float* DT, const float* cw, const float* cb, const float* dt_bias, const float* a_log, const float* d_skip,
                 us* Y, float* ST, float* ACUM, float* DEC, us* CC) {
    us* Cs = (us*)smem; us* Bs = (us*)(smem + 18432); us* BT = (us*)(smem + 36864); us* XT = (us*)(smem + 54272); us* XS = (us*)(smem + 71680); us* Wm = (us*)(smem + 89088);
    float* av = (float*)(smem + 123904); float* dtv = (float*)(smem + 125440);
    int tid_l = threadIdx.x; asm volatile("" : "+v"(tid_l));
    const int tid = tid_l, wave = tid >> 6, lane = tid & 63, hf = lane >> 5;
    const int t0 = (tid >> 4) * 4, cc = (tid & 15) * 4, row0 = c * 128 + t0;
    if (wave < 3) {
        const int h = 3 * g + wave; const float A = -__expf(a_log[h]), bias = dt_bias[h];
        const int s0 = 2 * lane, s1 = s0 + 1;
        const float dt0 = softplus(DT[(c * 128 + s0) * 8 + h] + bias), dt1 = softplus(DT[(c * 128 + s1) * 8 + h] + bias);
        const float x0 = dt0 * A, x1 = x0 + dt1 * A;
        float incl = x1;
#pragma unroll
        for (int o = 1; o < 64; o <<= 1) { const float y = __shfl_up(incl, o); if (lane >= o) incl += y; }
        const float excl = incl - x1;
        av[wave * 128 + s0] = excl + x0; av[wave * 128 + s1] = excl + x1; dtv[wave * 128 + s0] = dt0; dtv[wave * 128 + s1] = dt1;
        ACUM[(c * 128 + s0) * 8 + h] = excl + x0; ACUM[(c * 128 + s1) * 8 + h] = excl + x1;
        if (lane == 63) DEC[c * 8 + h] = __expf(incl);
    }
    {
        float o[4][4];
        conv4x4(XBC, row0, 384 + 64 * g + cc, cw, cb, o);
#pragma unroll
        for (int tt = 0; tt < 4; ++tt) *(u32x2*)(Bs + (t0 + tt) * 72 + cc) = pk4(o[tt][0], o[tt][1], o[tt][2], o[tt][3]);
#pragma unroll
        for (int j = 0; j < 4; ++j) *(u32x2*)(BT + (cc + j) * 136 + t0) = pk4(o[0][j], o[1][j], o[2][j], o[3][j]);
        conv4x4(XBC, row0, 512 + 64 * g + cc, cw, cb, o);
#pragma unroll
        for (int tt = 0; tt < 4; ++tt) { const u32x2 v = pk4(o[tt][0], o[tt][1], o[tt][2], o[tt][3]); *(u32x2*)(Cs + (t0 + tt) * 72 + cc) = v; *(u32x2*)(CC + (size_t)(row0 + tt) * 128 + 64 * g + cc) = v; }
    }
    __syncthreads();
    const int tb = wave >> 1, sb0 = 2 * (wave & 1);
    f32x16 cbm[2];
#pragma unroll
    for (int i = 0; i < 16; ++i) { cbm[0][i] = 0.f; cbm[1][i] = 0.f; }
    mm32(cbm[0], Cs + tb * 32 * 72, 72, Bs + sb0 * 32 * 72, 72, 4, lane);
    mm32(cbm[1], Cs + tb * 32 * 72, 72, Bs + (sb0 + 1) * 32 * 72, 72, 4, lane);
#pragma unroll 1
    for (int hh = 0; hh < 3; ++hh) {
        const int h = 3 * g + hh;
        {
            float o[4][4];
            conv4x4(XBC, row0, 64 * h + cc, cw, cb, o);
            float dte[4];
#pragma unroll
            for (int tt = 0; tt < 4; ++tt) dte[tt] = __expf(av[hh * 128 + 127] - av[hh * 128 + t0 + tt]) * dtv[hh * 128 + t0 + tt];
#pragma unroll
            for (int j = 0; j < 4; ++j) { *(u32x2*)(XT + (cc + j) * 136 + t0) = pk4(o[0][j], o[1][j], o[2][j], o[3][j]);
                *(u32x2*)(XS + (cc + j) * 136 + t0) = pk4(o[0][j] * dte[0], o[1][j] * dte[1], o[2][j] * dte[2], o[3][j] * dte[3]); }
        }
#pragma unroll
        for (int blk = 0; blk < 2; ++blk) {
            const int s = (sb0 + blk) * 32 + (lane & 31); const float as = av[hh * 128 + s], dts = dtv[hh * 128 + s];
#pragma unroll
            for (int i = 0; i < 16; ++i) { const int t_ = tb * 32 + crow(i, hf);
                float w = cbm[blk][i] * __builtin_amdgcn_exp2f(fminf(av[hh * 128 + t_] - as, 0.f) * 1.4426950408889634f) * dts;
                w = (s <= t_) ? w : 0.f;
                Wm[t_ * 136 + s] = f2bf(w); }
        }
        __syncthreads();
        {
            const int pb = wave & 1; f32x16 acc;
#pragma unroll
            for (int i = 0; i < 16; ++i) acc[i] = 0.f;
            mm32(acc, Wm + tb * 32 * 136, 136, XT + pb * 32 * 136, 136, 8, lane);
            const int p = pb * 32 + (lane & 31); const float dsk = d_skip[h];
#pragma unroll
            for (int i = 0; i < 16; ++i) { const int t_ = tb * 32 + crow(i, hf); Y[(size_t)(c * 128 + t_) * 384 + h * 64 + p] = f2bf(acc[i] + bf2f(XT[p * 136 + t_]) * dsk); }
        }
        if (wave < 4) {
            const int pb = wave >> 1, nb = wave & 1; f32x16 acc;
#pragma unroll
            for (int i = 0; i < 16; ++i) acc[i] = 0.f;
            mm32(acc, XS + pb * 32 * 136, 136, BT + nb * 32 * 136, 136, 8, lane);
            const int n = nb * 32 + (lane & 31);
#pragma unroll
            for (int i = 0; i < 16; ++i) { const int p_ = pb * 32 + crow(i, hf); ST[((size_t)(c * 6 + h) * 64 + p_) * 64 + n] = acc[i]; }
        }
        __syncthreads();
    }
}

DI void gmlp_item(unsigned char* smem, int c, int h, const us* U, const us* V, const float* SSQ, const float* gv, const float* w_s, const float* b_s, us* mix) {
    us* Ws = (us*)smem; us* VTs = (us*)(smem + 34816);
    int tid_l = threadIdx.x; asm volatile("" : "+v"(tid_l));
    const int tid = tid_l, wave = tid >> 6, lane = tid & 63, hf = lane >> 5;
    const int t = tid >> 2, cq = (tid & 3) * 16, row = c * 128 + t;
    {
        const f32x4 a = *(const f32x4*)(SSQ + row * 32), b = *(const f32x4*)(SSQ + row * 32 + 4);
        const float rstd = rsqrtf((((a[0] + a[1]) + (a[2] + a[3])) + ((b[0] + b[1]) + (b[2] + b[3]))) * (1.f / 256.f) + EPS);
        float x[16]; ld16bf(V + (size_t)row * 256 + 64 * h + cq, x);
#pragma unroll
        for (int j = 0; j < 16; ++j) VTs[(cq + j) * 136 + t] = f2bf(x[j] * rstd * gv[64 * h + cq + j]);
        const int s0 = (tid & 3) * 32; const float* wr = w_s + ((size_t)h * 128 + t) * 128 + s0;
#pragma unroll
        for (int q = 0; q < 4; ++q) {
            const f32x4 w0 = *(const f32x4*)(wr + 8 * q), w1 = *(const f32x4*)(wr + 8 * q + 4); f32x4 m0, m1;
#pragma unroll
            for (int e = 0; e < 4; ++e) { m0[e] = (s0 + 8 * q + e <= t) ? w0[e] : 0.f; m1[e] = (s0 + 8 * q + 4 + e <= t) ? w1[e] : 0.f; }
            st_bf16x8(Ws + t * 136 + s0 + 8 * q, m0, m1);
        }
    }
    const int tb = wave >> 1, db = wave & 1, d = db * 32 + (lane & 31);
    float uv[16], bv[16];
#pragma unroll
    for (int i = 0; i < 16; ++i) { const int t_ = tb * 32 + crow(i, hf); uv[i] = bf2f(U[((size_t)c * 128 + t_) * 256 + 64 * h + d]); bv[i] = b_s[h * 128 + t_]; }
    __syncthreads();
    {
        f32x16 acc;
#pragma unroll
        for (int i = 0; i < 16; ++i) acc[i] = 0.f;
        mm32(acc, Ws + tb * 32 * 136, 136, VTs + db * 32 * 136, 136, 8, lane);
#pragma unroll
        for (int i = 0; i < 16; ++i) { const int t_ = tb * 32 + crow(i, hf); const size_t r_ = (size_t)c * 128 + t_;
            mix[r_ * DM + 64 * h + d] = f2bf((acc[i] + bv[i]) * uv[i]); }
    }
    __syncthreads();
}

DI void ssd_final_item(unsigned char* smem, int c, int g, const us* CC, const float* ST, const us* Y, const float* ACUM, const us* ZS, const float* ng, us* mix) {
    us* Cs = (us*)smem; us* HP = (us*)(smem + 18432); float* YG = (float*)(smem + 27648);
    int tid_l = threadIdx.x; asm volatile("" : "+v"(tid_l));
    const int tid = tid_l, wave = tid >> 6, lane = tid & 63, hf = lane >> 5;
    const int t = tid >> 2, cq = (tid & 3) * 16;
    const int hp_p = tid >> 3, hp_n0 = (tid & 7) * 8;
    const int tb = wave >> 1, pb = wave & 1, p = pb * 32 + (lane & 31);
    f32x4 h0, h1;
    { const float* src = ST + ((size_t)(c * 6 + 3 * g) * 64 + hp_p) * 64 + hp_n0; h0 = *(const f32x4*)src; h1 = *(const f32x4*)(src + 4); }
    { const us* src = CC + (size_t)(c * 128 + t) * 128 + 64 * g + cq; *(u32x4*)(Cs + t * 72 + cq) = *(const u32x4*)src; *(u32x4*)(Cs + t * 72 + cq + 8) = *(const u32x4*)(src + 8); }
#pragma unroll 1
    for (int hh = 0; hh < 3; ++hh) {
        const int h = 3 * g + hh;
        st_bf16x8(HP + hp_p * 72 + hp_n0, h0, h1);
        if (hh < 2) { const float* src = ST + ((size_t)(c * 6 + h + 1) * 64 + hp_p) * 64 + hp_n0; h0 = *(const f32x4*)src; h1 = *(const f32x4*)(src + 4); }
        float yv[16], av[16], zv[16];
#pragma unroll
        for (int i = 0; i < 16; ++i) { const size_t r_ = (size_t)c * 128 + tb * 32 + crow(i, hf);
            yv[i] = bf2f(Y[r_ * 384 + h * 64 + p]); av[i] = ACUM[r_ * 8 + h]; zv[i] = bf2f(ZS[r_ * 384 + h * 64 + p]); }
        __syncthreads();
        {
            f32x16 acc;
#pragma unroll
            for (int i = 0; i < 16; ++i) acc[i] = 0.f;
            mm32(acc, Cs + tb * 32 * 72, 72, HP + pb * 32 * 72, 72, 4, lane);
#pragma unroll
            for (int i = 0; i < 16; ++i) { const int t_ = tb * 32 + crow(i, hf);
                YG[t_ * 196 + hh * 64 + p] = (yv[i] + __expf(av[i]) * acc[i]) * zv[i]; }
        }
        __syncthreads();
    }
    {
        const int part = tid & 3; const float* yr = YG + t * 196 + part * 48; float v[48]; float ss = 0.f;
#pragma unroll
        for (int q = 0; q < 12; ++q) { const f32x4 a = *(const f32x4*)(yr + 4 * q); v[4 * q] = a[0]; v[4 * q + 1] = a[1]; v[4 * q + 2] = a[2]; v[4 * q + 3] = a[3]; ss += (a[0] * a[0] + a[1] * a[1]) + (a[2] * a[2] + a[3] * a[3]); }
        ss += __shfl_xor(ss, 1); ss += __shfl_xor(ss, 2);
        const float rstd = rsqrtf(ss * (1.f / 192.f) + EPS);
        const float* gp = ng + 192 * g + part * 48; us* dst = mix + (size_t)(c * 128 + t) * DM + 256 + 192 * g + part * 48;
#pragma unroll
        for (int q = 0; q < 6; ++q) { f32x4 a, b;
#pragma unroll
            for (int e = 0; e < 4; ++e) { a[e] = v[8 * q + e] * rstd * gp[8 * q + e]; b[e] = v[8 * q + 4 + e] * rstd * gp[8 * q + 4 + e]; }
            st_bf16x8(dst + 8 * q, a, b); }
    }
    __syncthreads();
}

constexpr int ATT_NQB = 64, ATT_ITEMS = 960;
DI int att_slot(int h, int qb, int kc) { const int g = qb >> 4, b = qb & 15; const int base = (g == 1) ? 2 * b : (g == 2) ? 32 + 3 * b : 80 + 4 * b; return h * 144 + base + kc; }
DI size_t att_slot_off(int slot) { return (size_t)slot * 16384; }
DI void att_decode(int u, int& h, int& qb, int& kc) {
    if (u < 576) { h = u % 6; const int v = u / 6;
        if (v < 16) { qb = 16 + v; kc = 0; } else if (v < 48) { const int w = v - 16; qb = 32 + (w >> 1); kc = w & 1; } else { const int w = v - 48; qb = 48 + w / 3; kc = w % 3; }
    } else { const int d = u - 576; h = d % 6; const int e = d / 6, q = e & 3; qb = 16 * q + 15 - (e >> 2); kc = q; }
}
constexpr int AT_KB = 64 * 208, AT_VB = 64 * 144;
DI void attn_unit(unsigned char* smem, const us* Q, const us* K, const us* VT, us* mix, us* PO, float* PML, int h, int qb, int kc) {
    int tid_l = threadIdx.x; asm volatile("" : "+v"(tid_l));
    const int tid = tid_l, wave = tid >> 6, lane = tid & 63, r = lane & 31, hf = lane >> 5;
    const int q0 = qb * 256 + wave * 32, qrow = q0 + r;
    bf16x8 qf[6];
#pragma unroll
    for (int ks = 0; ks < 6; ++ks) qf[ks] = *(const bf16x8*)(Q + ((size_t)h * M + qrow) * 96 + 16 * ks + 8 * hf);
    f32x16 o0, o1;
#pragma unroll
    for (int i = 0; i < 16; ++i) { o0[i] = 0.f; o1[i] = 0.f; }
    float mrun = -1e30f, lrun = 0.f;
    const int t0 = 64 * kc, tend = (64 * (kc + 1) < 4 * (qb + 1)) ? 64 * (kc + 1) : 4 * (qb + 1), ntiles = tend - t0, tg = __builtin_amdgcn_readfirstlane(q0 >> 6);
    const bool masked = tg < tend; const int tlw = (masked ? tg : tend - 1) - t0;
    const int id1 = 512 + (tid & 255);
    const int kg0 = tid * 8, kl0 = (tid / 12) * 104 + (tid % 12) * 8, kg1 = id1 * 8, kl1 = (id1 / 12) * 104 + (id1 % 12) * 8;
    const int vl0 = (tid >> 3) * 72 + ((tid & 7) >> 1) * 16 + (tid & 1) * 4;
    const us* Kg = K + (size_t)h * M * 96; const us* Vg = VT + (size_t)(h * 64 + (tid >> 3)) * M + (tid & 7) * 8;
    us* Kb0 = (us*)smem; us* Kb1 = (us*)(smem + AT_KB); us* Vb0 = (us*)(smem + 2 * AT_KB); us* Vb1 = (us*)(smem + 2 * AT_KB + AT_VB);
    u32x4 ka0, ka1, va, kb0, kb1, vb;
#define AT_LDK(R0, R1, t) do { const size_t kn_ = (size_t)(t0 + ((t) < ntiles ? (t) : ntiles - 1)) * 64; R0 = *(const u32x4*)(Kg + kn_ * 96 + kg0); R1 = *(const u32x4*)(Kg + kn_ * 96 + kg1); } while (0)
#define AT_LDV(R, t) do { const size_t kn_ = (size_t)(t0 + ((t) < ntiles ? (t) : ntiles - 1)) * 64; R = *(const u32x4*)(Vg + kn_); } while (0)
#define AT_STK(R0, R1, Kb) do { *(u32x4*)((Kb) + kl0) = R0; *(u32x4*)((Kb) + kl1) = R1; } while (0)
#define AT_STV(R, Vb) do { *(u32x2*)((Vb) + vl0) = (u32x2){R.x, R.y}; *(u32x2*)((Vb) + vl0 + 8) = (u32x2){R.z, R.w}; } while (0)
#define AT_QK(S0, S1, Kb) do { \
        _Pragma("unroll") for (int i = 0; i < 16; ++i) { S0[i] = 0.f; S1[i] = 0.f; } \
        _Pragma("unroll") for (int ks = 0; ks < 6; ++ks) { \
            const bf16x8 a0 = *(const bf16x8*)((Kb) + r * 104 + 16 * ks + 8 * hf), a1 = *(const bf16x8*)((Kb) + (32 + r) * 104 + 16 * ks + 8 * hf); \
            S0 = MFMA32(a0, qf[ks], S0); S1 = MFMA32(a1, qf[ks], S1); } } while (0)
#define AT_MASK(S0, S1, kbase) do { \
        _Pragma("unroll") for (int i = 0; i < 16; ++i) { const int key = (kbase) + crow(i, hf); if (key > qrow) S0[i] = -1e30f; if (key + 32 > qrow) S1[i] = -1e30f; } } while (0)
#define AT_SMPV(S0, S1, Vb) do { \
        float mx = fmaxf(S0[0], S1[0]); \
        _Pragma("unroll") for (int i = 1; i < 16; ++i) mx = fmaxf(mx, fmaxf(S0[i], S1[i])); \
        mx = fmaxf(mx, __shfl_xor(mx, 32)); \
        const float mnew = fmaxf(mrun, mx), alpha = __builtin_amdgcn_exp2f(mrun - mnew); \
        float rs = 0.f; \
        _Pragma("unroll") for (int i = 0; i < 16; ++i) { S0[i] = __builtin_amdgcn_exp2f(S0[i] - mnew); S1[i] = __builtin_amdgcn_exp2f(S1[i] - mnew); rs += S0[i] + S1[i]; } \
        rs += __shfl_xor(rs, 32); \
        lrun = lrun * alpha + rs; mrun = mnew; \
        if (__builtin_amdgcn_ballot_w64(alpha != 1.0f)) { _Pragma("unroll") for (int i = 0; i < 16; ++i) { o0[i] *= alpha; o1[i] *= alpha; } } \
        _Pragma("unroll") for (int j4 = 0; j4 < 4; ++j4) { \
            const int kb = j4 >> 1, s_ = j4 & 1; u32x4 pw; \
            if (kb == 0) { pw.x = pk2(S0[8 * s_], S0[8 * s_ + 1]); pw.y = pk2(S0[8 * s_ + 2], S0[8 * s_ + 3]); pw.z = pk2(S0[8 * s_ + 4], S0[8 * s_ + 5]); pw.w = pk2(S0[8 * s_ + 6], S0[8 * s_ + 7]); } \
            else         { pw.x = pk2(S1[8 * s_], S1[8 * s_ + 1]); pw.y = pk2(S1[8 * s_ + 2], S1[8 * s_ + 3]); pw.z = pk2(S1[8 * s_ + 4], S1[8 * s_ + 5]); pw.w = pk2(S1[8 * s_ + 6], S1[8 * s_ + 7]); } \
            const bf16x8 pf = __builtin_bit_cast(bf16x8, pw); \
            const int koff = kb * 32 + 16 * s_ + 8 * hf; \
            const bf16x8 a0 = *(const bf16x8*)((Vb) + r * 72 + koff), a1 = *(const bf16x8*)((Vb) + (32 + r) * 72 + koff); \
            o0 = MFMA32(a0, pf, o0); o1 = MFMA32(a1, pf, o1); } } while (0)
    AT_LDK(ka0, ka1, 0); AT_LDV(va, 0); AT_STK(ka0, ka1, Kb0); AT_STV(va, Vb0);
    AT_LDK(ka0, ka1, 1); AT_STK(ka0, ka1, Kb1);
    AT_LDK(kb0, kb1, 2); AT_LDV(vb, 1);
    __syncthreads();
    f32x16 sa0, sa1, sb0, sb1;
    AT_QK(sa0, sa1, Kb0);
    __syncthreads();
    int t = 0;
#define AT_EVEN_TAIL() do { AT_STK(kb0, kb1, Kb0); AT_STV(vb, Vb1); __syncthreads(); } while (0)
#define AT_ODD_TAIL() do { AT_STK(ka0, ka1, Kb1); AT_STV(va, Vb0); __syncthreads(); } while (0)
#pragma unroll 1
    for (; t + 1 < tlw; t += 2) {
        AT_LDK(ka0, ka1, t + 3); AT_LDV(va, t + 2);
        AT_QK(sb0, sb1, Kb1);
        AT_SMPV(sa0, sa1, Vb0);
        AT_EVEN_TAIL();
        AT_LDK(kb0, kb1, t + 4); AT_LDV(vb, t + 3);
        AT_QK(sa0, sa1, Kb0);
        AT_SMPV(sb0, sb1, Vb1);
        AT_ODD_TAIL();
    }
    if (t < tlw) {
        AT_LDK(ka0, ka1, t + 3); AT_LDV(va, t + 2);
        AT_QK(sb0, sb1, Kb1);
        AT_SMPV(sa0, sa1, Vb0);
        AT_EVEN_TAIL();
        ++t;
        AT_LDK(kb0, kb1, t + 3); AT_LDV(vb, t + 2);
        if (masked) AT_MASK(sb0, sb1, (t0 + t) * 64);
        AT_SMPV(sb0, sb1, Vb1);
        AT_ODD_TAIL();
        ++t;
    } else {
        AT_LDK(ka0, ka1, t + 3); AT_LDV(va, t + 2);
        if (masked) AT_MASK(sa0, sa1, (t0 + t) * 64);
        AT_SMPV(sa0, sa1, Vb0);
        AT_EVEN_TAIL();
        ++t;
    }
#pragma unroll 1
    for (; t < ntiles; ++t) {
        if (t & 1) { AT_LDK(kb0, kb1, t + 3); AT_LDV(vb, t + 2); AT_ODD_TAIL(); } else { AT_LDK(ka0, ka1, t + 3); AT_LDV(va, t + 2); AT_EVEN_TAIL(); }
    }
#undef AT_EVEN_TAIL
#undef AT_ODD_TAIL
#undef AT_LDK
#undef AT_LDV
#undef AT_STK
#undef AT_STV
#undef AT_QK
#undef AT_MASK
#undef AT_SMPV
    if (qb < 16) {
        const float inv = 1.f / lrun;
        us* dst = mix + (size_t)qrow * DM + 640 + h * 64;
#pragma unroll
        for (int gq = 0; gq < 4; ++gq) {
            u32x2 w0, w1;
            w0.x = pk2(o0[4 * gq] * inv, o0[4 * gq + 1] * inv); w0.y = pk2(o0[4 * gq + 2] * inv, o0[4 * gq + 3] * inv);
            w1.x = pk2(o1[4 * gq] * inv, o1[4 * gq + 1] * inv); w1.y = pk2(o1[4 * gq + 2] * inv, o1[4 * gq + 3] * inv);
            *(u32x2*)(dst + 8 * gq + 4 * hf) = w0; *(u32x2*)(dst + 32 + 8 * gq + 4 * hf) = w1;
        }
    } else {
        const int slot = att_slot(h, qb, kc), rowl = wave * 32 + r;
        us* po = PO + att_slot_off(slot) + (size_t)rowl * 64;
#pragma unroll
        for (int gq = 0; gq < 4; ++gq) {
            u32x2 w0, w1;
            w0.x = pk2(o0[4 * gq], o0[4 * gq + 1]); w0.y = pk2(o0[4 * gq + 2], o0[4 * gq + 3]);
            w1.x = pk2(o1[4 * gq], o1[4 * gq + 1]); w1.y = pk2(o1[4 * gq + 2], o1[4 * gq + 3]);
            *(u32x2*)(po + 8 * gq + 4 * hf) = w0; *(u32x2*)(po + 32 + 8 * gq + 4 * hf) = w1;
        }
        if (hf == 0) { PML[((size_t)slot * 256 + rowl) * 2] = mrun; PML[((size_t)slot * 256 + rowl) * 2 + 1] = lrun; }
    }
}
DI void attn_merge(const us* PO, const float* PML, us* mix, int h, int qb) {
    int tid = threadIdx.x; asm volatile("" : "+v"(tid));
    const int row = tid >> 1, c0 = (tid & 1) * 32, nch = (qb >> 4) + 1;
    float mk[4], lk[4], M_ = -1e30f;
#pragma unroll
    for (int k = 0; k < 4; ++k) if (k < nch) { const size_t ix = ((size_t)att_slot(h, qb, k) * 256 + row) * 2; mk[k] = PML[ix]; lk[k] = PML[ix + 1]; M_ = fmaxf(M_, mk[k]); }
    float L = 0.f, wk[4];
#pragma unroll
    for (int k = 0; k < 4; ++k) if (k < nch) { wk[k] = __builtin_amdgcn_exp2f(mk[k] - M_); L += wk[k] * lk[k]; }
    const float inv = 1.f / L;
    f32x4 acc[8];
#pragma unroll
    for (int j = 0; j < 8; ++j) acc[j] = (f32x4){0.f, 0.f, 0.f, 0.f};
#pragma unroll
    for (int k = 0; k < 4; ++k) if (k < nch) { const us* po = PO + att_slot_off(att_slot(h, qb, k)) + (size_t)row * 64 + c0; const float w = wk[k] * inv;
#pragma unroll
        for (int j = 0; j < 4; ++j) { const u32x4 v = *(const u32x4*)(po + 8 * j);
            acc[2 * j] += (f32x4){__uint_as_float(v.x << 16), __uint_as_float(v.x & 0xffff0000u), __uint_as_float(v.y << 16), __uint_as_float(v.y & 0xffff0000u)} * w;
            acc[2 * j + 1] += (f32x4){__uint_as_float(v.z << 16), __uint_as_float(v.z & 0xffff0000u), __uint_as_float(v.w << 16), __uint_as_float(v.w & 0xffff0000u)} * w; } }
    us* dst = mix + (size_t)(qb * 256 + row) * DM + 640 + h * 64 + c0;
#pragma unroll
    for (int j = 0; j < 4; ++j) st_bf16x8(dst + 8 * j, acc[2 * j], acc[2 * j + 1]);
}
DI const void* ldp_g(const unsigned char* lds, int i, const unsigned char* gbase) {
    const volatile unsigned* t = (const volatile unsigned*)(lds + 131328) + 2 * i;
    const unsigned lo = __builtin_amdgcn_readfirstlane(t[0]), hi = __builtin_amdgcn_readfirstlane(t[1]);
    const long long off = (long long)((((unsigned long long)hi << 32) | lo) - (unsigned long long)gbase);
    return (const void*)(gbase + off);
}
#define LAS __attribute__((address_space(3)))
#define XB_TMO      128
#define XB_XCNT(j)  (256  + 64 * (j))
#define XB_XSUB(j)  (1280 + 64 * (j))
#define XB_XGEN(j)  (2304 + 64 * (j))
#define XB_TOP      3328
#define XB_TOPGEN   3392
#define XCD_BAR_WORDS 3456
#define XB_SPIN_CAP (1u << 18)

__device__ __forceinline__ unsigned xb_ld(unsigned* p)              { return __hip_atomic_load(p, __ATOMIC_RELAXED, __HIP_MEMORY_SCOPE_AGENT); }
__device__ __forceinline__ unsigned xb_add(unsigned* p, unsigned v) { return __hip_atomic_fetch_add(p, v, __ATOMIC_RELAXED, __HIP_MEMORY_SCOPE_AGENT); }
__device__ __forceinline__ unsigned xb_xcc_id() { return (unsigned)__builtin_amdgcn_s_getreg((3 << 11) | 20) & 0xFu; }
#define XB_SPIN(cond, bar) do { unsigned _sp = 0; while (cond) { __builtin_amdgcn_s_sleep(1); \
    if ((++_sp & 255u) == 0u) { if (xb_ld(&(bar)[XB_TMO])) break; if (_sp > XB_SPIN_CAP) { atomicAdd(&(bar)[XB_TMO], 1u); break; } } } } while (0)

struct XcdBarrier {
    unsigned* bar; unsigned x;
    volatile LAS unsigned* st;
};

__device__ __forceinline__ XcdBarrier xcd_barrier_post(unsigned* bar, volatile LAS unsigned* st) {
    XcdBarrier b; b.bar = bar; b.x = xb_xcc_id(); b.st = st;
    if (threadIdx.x == 0) (void)xb_add(&bar[XB_XCNT(b.x)], 1u);
    return b;
}
__device__ __forceinline__ void xcd_barrier_complete(unsigned* bar, unsigned x, unsigned& nloc, unsigned& nx) {
    const unsigned G = gridDim.x * gridDim.y * gridDim.z;
    unsigned sum, cnt, mine, sp = 0u;
    for (;;) {
        sum = 0u; cnt = 0u; mine = 0u;
#pragma unroll
        for (unsigned j = 0; j < 16; ++j) { const unsigned c = xb_ld(&bar[XB_XCNT(j)]); sum += c; cnt += (c > 0u) ? 1u : 0u; mine = (j == x) ? c : mine; }
        if (sum == G) break;
        __builtin_amdgcn_s_sleep(1);
        if ((++sp & 255u) == 0u) { if (xb_ld(&bar[XB_TMO])) break; if (sp > XB_SPIN_CAP) { atomicAdd(&bar[XB_TMO], 1u); break; } }
    }
    nloc = mine > 0u ? mine : 1u; nx = cnt > 0u ? cnt : 1u;
}

__device__ __forceinline__ void xcd_barrier(const XcdBarrier& b) {
    asm volatile("s_waitcnt vmcnt(0)" ::: "memory");
    __syncthreads();
    if (threadIdx.x == 0) {
        unsigned* bar = b.bar;
        __builtin_amdgcn_s_waitcnt(0);
        unsigned nloc = b.st[0], nx = b.st[1];
        if (nloc == 0u) { xcd_barrier_complete(bar, b.x, nloc, nx); b.st[0] = nloc; b.st[1] = nx; }
        const unsigned old = xb_add(&bar[XB_XSUB(b.x)], 1u);
        const unsigned gen = old / nloc;
        if (old + 1u == (gen + 1u) * nloc) {
            __builtin_amdgcn_fence(__ATOMIC_RELEASE, "agent");
            asm volatile("s_waitcnt vmcnt(0)" ::: "memory");
            const unsigned og = xb_add(&bar[XB_TOP], 1u);
            const unsigned tg = og / nx;
            if (og + 1u == (tg + 1u) * nx) xb_add(&bar[XB_TOPGEN], 1u);
            else XB_SPIN(xb_ld(&bar[XB_TOPGEN]) == tg, bar);
            __builtin_amdgcn_fence(__ATOMIC_ACQUIRE, "agent");
            xb_add(&bar[XB_XGEN(b.x)], 1u);
            asm volatile("s_waitcnt vmcnt(0)" ::: "memory");
        } else {
            XB_SPIN(xb_ld(&bar[XB_XGEN(b.x)]) == gen, bar);
            __builtin_amdgcn_fence(__ATOMIC_ACQUIRE, "agent");
            asm volatile("s_waitcnt vmcnt(0)" ::: "memory");
        }
    }
    __syncthreads();
}
constexpr int NTHR = 512;
#define XB_ST_OFF 131136
#define GSYNC() do { XcdBarrier xb_; xb_.bar = (unsigned*)(WSP + WS_CTL) + 1024; xb_.x = xb_xcc_id(); xb_.st = (volatile LAS unsigned*)(glds + XB_ST_OFF); xcd_barrier(xb_); } while (0)
#define INP(i) ((const float*)ldp_g(lds, (i), gbase))
#define OUTP ((float*)ldp_g(lds, 21, gbase))
#define WSP ((unsigned char*)ldp_g(lds, 22, gbase))

DI void conv_list_a(unsigned char* lds, const unsigned char* gbase, unsigned char* ws, int l, int wo_buf, int w0, int nw, int wave, int lane) {
    float* scr = (float*)(lds + wave * 8448);
    const float* w_in = INP(2) + (size_t)l * DM * DIN; const float* w_qb = INP(13) + (size_t)l * 384 * 576; const float* w_kvb = INP(15) + (size_t)l * 256 * 768; const float* w_out = INP(16) + (size_t)l * DM * DM;
    const float* g1 = INP(1) + l * DM; const float* gq = INP(12) + l * 384; const float* gkv = INP(14) + l * 256;
    us* Win_t = (us*)(ws + WS_WIN); us* Wqb_t = (us*)(ws + WS_WQB); us* Wkn_t = (us*)(ws + WS_WKN); us* Wv_t = (us*)(ws + WS_WV); us* Wout_t = (us*)(ws + (wo_buf ? WS_WOUT2 : WS_WOUT));
    constexpr int I_IN = 16 * 72, I_QB = 6 * 24, I_KN = 4 * 16, I_V = 4 * 16, I_OUT = 16 * 32, NIT = I_IN + I_QB + I_KN + I_V + I_OUT;
    for (int it = w0; it < NIT; it += nw) {
        int r = it;
        if (r < I_IN) { tr_item<1>(w_in, DM, DIN, Win_t, g1, scr, r, 72, lane); continue; } r -= I_IN;
        if (r < I_QB) { tr_item<2>(w_qb, 384, 576, Wqb_t, gq, scr, r, 24, lane); continue; } r -= I_QB;
        if (r < I_KN) { tr_item<3>(w_kvb, 256, 768, Wkn_t, gkv, scr, r, 16, lane); continue; } r -= I_KN;
        if (r < I_V) { tr_item<4>(w_kvb, 256, 768, Wv_t, gkv, scr, r, 16, lane); continue; } r -= I_V;
        tr_item_v4(w_out, DM, DM, Wout_t, nullptr, scr, r, 32, lane);
    }
}
DI void conv_list_b(unsigned char* lds, const unsigned char* gbase, unsigned char* ws, int l, int w0, int nw, int wave, int lane) {
    float* scr = (float*)(lds + wave * 8448);
    const float* w1 = INP(18) + (size_t)l * DM * FF; const float* w2 = INP(19) + (size_t)l * FF * DM; const float* g2 = INP(17) + l * DM;
    us* W1_t = (us*)(ws + WS_W1); us* W2_t = (us*)(ws + WS_W2);
    constexpr int I_1 = 16 * 128, I_2 = 64 * 32;
    for (int it = w0; it < I_1 + I_2; it += nw) {
        if (it < I_1) tr_item_v4(w1, DM, FF, W1_t, g2, scr, it, 128, lane);
        else tr_item_v4(w2, FF, DM, W2_t, nullptr, scr, it - I_1, 32, lane);
    }
}

__global__ void __launch_bounds__(NTHR, 2) fwd_megakernel(Params p) {
    extern __shared__ __attribute__((aligned(16))) unsigned char lds[];
    const int tid = threadIdx.x, lane = tid & 63, wave = __builtin_amdgcn_readfirstlane(tid >> 6);
    const int G = gridDim.x, bid = blockIdx.x, gw = bid * 8 + wave, NGW = G * 8;
    {
        unsigned long long* tab = (unsigned long long*)(lds + 131328);
        if (tid == 0) {
#pragma unroll
            for (int i = 0; i < 21; ++i) tab[i] = (unsigned long long)p.in[i];
            tab[21] = (unsigned long long)p.out; tab[22] = (unsigned long long)p.ws;
        }
        if (tid < 2) ((volatile unsigned*)(lds + XB_ST_OFF))[tid] = 0u;
        __syncthreads();
    }
    PG8_LAS unsigned char* glds = (PG8_LAS unsigned char*)lds;
    const unsigned char* gbase = p.ws;
    (void)xcd_barrier_post((unsigned*)(WSP + WS_CTL) + 1024, (volatile LAS unsigned*)(glds + XB_ST_OFF));

    {
        unsigned char* ws = WSP; float* ROPE = (float*)(ws + WS_ROPE);
        for (int idx = bid * NTHR + tid; idx < M * 16; idx += G * NTHR) {
            const int pos = idx >> 4, i = idx & 15;
            const float inv_freq = powf(10000.0f, -(float)i / 16.0f);
            const float ang = (float)pos * inv_freq;
            const double rev = (double)ang * 0.15915494309189535;
            const float fr = (float)(rev - rint(rev));
            ROPE[2 * idx] = __builtin_amdgcn_cosf(fr); ROPE[2 * idx + 1] = __builtin_amdgcn_sinf(fr);
        }
        conv_list_a(lds, gbase, ws, 0, 0, gw, NGW, wave, lane);
        x_to_bf16_ssq(INP(0), (us*)(ws + WS_XN), (float*)(ws + WS_SSQX), gw, NGW, lane);
    }
    if (gridDim.x == 0x7fffffffu) cg::this_grid().sync();
    GSYNC();

#pragma unroll 1
    for (int l = 0; l < NL; ++l) {
        {
            unsigned char* ws = WSP;
            pg8::Gemm g{(us*)(ws + WS_XN), (us*)(ws + WS_WIN), M, DINP, DM}; pg8::StaticOrder S; S.init(M, DINP, G, bid);
            EpiIn E{ws};
            prep_rstd(S, (const float*)(ws + WS_SSQX), (float*)(ws + WS_RSTD));
            pg8::gemm_phase<EpiIn, pg8::StaticOrder, true, true>(glds, g, S, E);
            __syncthreads();
            if (G > 64) { if (bid >= 64) conv_list_b(lds, gbase, ws, l, (bid - 64) * 8 + wave, (G - 64) * 8, wave, lane); }
            else conv_list_b(lds, gbase, ws, l, gw, NGW, wave, lane);
        }
        GSYNC();
        {
            unsigned char* ws = WSP;
            us* CQ = (us*)(ws + WS_CQ); us* CKV = (us*)(ws + WS_CKV); us* Q = (us*)(ws + WS_Q); us* K = (us*)(ws + WS_K); us* VT = (us*)(ws + WS_VT);
            float* SSQ = (float*)(ws + WS_SSQ); float* ROPE = (float*)(ws + WS_ROPE);
            { pg8::Gemm g{CQ, (us*)(ws + WS_WQB), M, 768, 384}; pg8::StaticOrder S; S.init(M, 768, G, bid); EpiQ E{Q, SSQ, ROPE}; pg8::gemm_phase<EpiQ, pg8::StaticOrder, true, true>(glds, g, S, E); }
            __syncthreads();
            { pg8::Gemm g{CKV, (us*)(ws + WS_WKN), M, 512, 256}; pg8::StaticOrder S; S.init(M, 512, G, (bid + 64) % G); EpiKn E{K, SSQ}; pg8::gemm_phase<EpiKn, pg8::StaticOrder, true, true>(glds, g, S, E); }
            __syncthreads();
            { pg8::Gemm g{(us*)(ws + WS_WV), CKV, 512, M, 256}; pg8::StaticOrder S; S.init(512, M, G, (bid + 192) % G); EpiVt E{VT, SSQ}; pg8::gemm_phase<EpiVt, pg8::StaticOrder, true, true>(glds, g, S, E); }
            __syncthreads();
            const float* cw = INP(6) + (size_t)l * 4 * 640; const float* cb = INP(7) + l * 640;
            for (int it = bid; it < 256; it += G)
                ssd_item(lds, it >> 1, it & 1, (us*)(ws + WS_XBC), (float*)(ws + WS_DT), cw, cb, INP(8) + l * 6, INP(9) + l * 6, INP(10) + l * 6,
                         (us*)OUTP  , (float*)(ws + WS_ST), (float*)(ws + WS_ACUM), (float*)(ws + WS_DEC), (us*)(ws + WS_CC));
            for (int it = bid; it < 512; it += G)
                gmlp_item(lds, it >> 2, it & 3, (us*)(ws + WS_U), (us*)(ws + WS_V), SSQ, INP(3) + l * 256, INP(4) + (size_t)l * 4 * 128 * 128, INP(5) + l * 4 * 128, (us*)(ws + WS_MIX));
        }
        GSYNC();
        {
            unsigned char* ws = WSP;
            float* ST = (float*)(ws + WS_ST); const float* DEC = (const float*)(ws + WS_DEC);
            int tl = threadIdx.x; asm volatile("" : "+v"(tl)); const int idx = bid * NTHR + tl;
            if (idx < 6 * 4096) {
                const int h = idx >> 12, pn = idx & 4095; float hs = 0.f;
#pragma unroll 1
                for (int c0 = 0; c0 < 128; c0 += 16) {
                    float tmp[16], dc[16];
#pragma unroll
                    for (int j = 0; j < 16; ++j) { tmp[j] = ST[((size_t)(c0 + j) * 6 + h) * 4096 + pn]; dc[j] = DEC[(c0 + j) * 8 + h]; }
#pragma unroll
                    for (int j = 0; j < 16; ++j) { ST[((size_t)(c0 + j) * 6 + h) * 4096 + pn] = hs; hs = dc[j] * hs + tmp[j]; }
                }
            }
            volatile unsigned* slot = (volatile unsigned*)(lds + 131200);
            {
            unsigned* qctr = (unsigned*)(ws + WS_CTL) + 64 * l;
            for (;;) {
                if (tid == 0) slot[0] = atomicAdd(qctr, 1u);
                __syncthreads();
                const unsigned uu = (unsigned)__builtin_amdgcn_readfirstlane((int)slot[0]);
                __syncthreads();
                if (uu >= (unsigned)ATT_ITEMS) break;
                int ah, aqb, akc; att_decode((int)uu, ah, aqb, akc);
                attn_unit(lds, (us*)(ws + WS_Q), (us*)(ws + WS_K), (us*)(ws + WS_VT), (us*)(ws + WS_MIX), (us*)(ws + 124 * MiB), (float*)(ws + 162 * MiB), ah, aqb, akc);
            }
            }
        }
        GSYNC();
        {
            unsigned char* ws = WSP;
            for (int it = bid; it < 288; it += G) attn_merge((const us*)(ws + 124 * MiB), (const float*)(ws + 162 * MiB), (us*)(ws + WS_MIX), it % 6, 16 + it / 6);
            for (int it = bid; it < 256; it += G)
                ssd_final_item(lds, it >> 1, it & 1, (us*)(ws + WS_CC), (float*)(ws + WS_ST), (us*)OUTP  , (float*)(ws + WS_ACUM), (us*)(ws + WS_ZS), INP(11) + l * 384, (us*)(ws + WS_MIX));
            if (l + 1 < NL) {
                if (G > 32) { if (bid >= 32) conv_list_a(lds, gbase, ws, l + 1, (l + 1) & 1, (bid - 32) * 8 + wave, (G - 32) * 8, wave, lane); }
                else conv_list_a(lds, gbase, ws, l + 1, (l + 1) & 1, gw, NGW, wave, lane);
            }
        }
        GSYNC();
        {
            unsigned char* ws = WSP;
            pg8::Gemm g{(us*)(ws + WS_MIX), (us*)(ws + ((l & 1) ? WS_WOUT2 : WS_WOUT)), M, DM, DM}; pg8::StaticOrder S; S.init(M, DM, G, bid);
            EpiRes E{(us*)(ws + WS_XN), (float*)(ws + WS_SSQX)};
            pg8::gemm_phase<EpiRes, pg8::StaticOrder, true, true>(glds, g, S, E);
        }
        GSYNC();
        {
            unsigned char* ws = WSP;
            pg8::Gemm g{(us*)(ws + WS_XN), (us*)(ws + WS_W1), M, FF, DM}; pg8::StaticOrder S; S.init(M, FF, G, bid); EpiRelu2 E{(us*)(ws + WS_H), (const float*)(ws + WS_RSTD)};
            prep_rstd(S, (const float*)(ws + WS_SSQX), (float*)(ws + WS_RSTD));
            pg8::gemm_phase<EpiRelu2, pg8::StaticOrder, true, true>(glds, g, S, E);
        }
        GSYNC();
        {
            unsigned char* ws = WSP;
            pg8::Gemm g{(us*)(ws + WS_H), (us*)(ws + WS_W2), M, DM, FF}; pg8::StaticOrder S; S.init(M, DM, G, bid);
            EpiRes E{(us*)(ws + WS_XN), (float*)(ws + WS_SSQX)};
            pg8::gemm_phase<EpiRes, pg8::StaticOrder, true, true>(glds, g, S, E);
        }
        GSYNC();
    }
    norm_rows_out((const us*)(WSP + WS_XN), OUTP, INP(20), gw, NGW, lane);
}

extern "C" void kernel_launch(void* const* d_in, const int* in_sizes, int n_in, void* d_out, int out_size, void* d_ws, size_t ws_size, hipStream_t stream) {
    static int grid = 0;
    if (grid == 0) {
        if (n_in != 21 || out_size != M * DM || ws_size < WS_END) { fprintf(stderr, "kernel_launch: unexpected shapes (n_in %d out %d ws %zu)\n", n_in, out_size, ws_size); grid = -1; return; }
        int dev = 0, cus = 0, per_cu = 0;
        (void)hipGetDevice(&dev); (void)hipDeviceGetAttribute(&cus, hipDeviceAttributeMultiprocessorCount, dev);
        (void)hipFuncSetAttribute((const void*)fwd_megakernel, hipFuncAttributeMaxDynamicSharedMemorySize, LDS_BYTES);
        (void)hipOccupancyMaxActiveBlocksPerMultiprocessor(&per_cu, (const void*)fwd_megakernel, NTHR, LDS_BYTES);
        if (per_cu < 1) { fprintf(stderr, "kernel_launch: occupancy query says %d blocks per CU\n", per_cu); per_cu = 1; }
        (void)hipGetLastError();
        grid = cus * per_cu;
    }
    if (grid < 0) return;
    (void)hipMemsetAsync((char*)d_ws + WS_CTL, 0, 32768, stream);
    Params p{};
    for (int i = 0; i < 21; ++i) p.in[i] = (const float*)d_in[i];
    p.out = (float*)d_out; p.ws = (unsigned char*)d_ws;
    void* args[] = {&p};
    hipError_t e = hipLaunchCooperativeKernel((const void*)fwd_megakernel, dim3(grid), dim3(NTHR), args, LDS_BYTES, stream);
    if (e != hipSuccess) fprintf(stderr, "cooperative launch failed: %s (grid %d)\n", hipGetErrorString(e), grid);
}
```
